# Optimizing an MI355X kernel written in HIP

```python
import math
import jax, jax.numpy as jnp
from jax import lax
import numpy as np

D_MODEL = 1024
BATCH = 4
SEQ = 4096
DEPTH = 2

CHUNK = 64
N_A_LAYERS = DEPTH // 2
N_B_LAYERS = DEPTH - N_A_LAYERS
N_DENSE_FFN = (DEPTH + 1) // 2
N_MOE_FFN = DEPTH // 2
DEEPNORM_ALPHA = (2.0 * DEPTH) ** 0.25
DEEPNORM_BETA = (8.0 * DEPTH) ** -0.25
LN_EPS = 1e-5

RET_HEADS = 4
RET_QK_DIM = D_MODEL // RET_HEADS
RET_V_WIDTH = 2 * D_MODEL
RET_V_DIM = RET_V_WIDTH // RET_HEADS
RET_IN_WIDTH = 2 * D_MODEL + 2 * RET_V_WIDTH
ROPE_BASE = 10000.0

SB_HEADS = 16
SB_HEAD_DIM = D_MODEL // SB_HEADS
SB_QBLOCK = 128

D_FF = 2816
N_EXPERTS = 8
TOP_K = 2
D_EXPERT = 3584

kernel_name = "retention_stickbreaking_yoco_moe_deepnorm"


def layer_norm(x, g, b):
    xf = x.astype(jnp.float32)
    mu = jnp.mean(xf, axis=-1, keepdims=True)
    var = jnp.mean(jnp.square(xf - mu), axis=-1, keepdims=True)
    y = (xf - mu) * lax.rsqrt(var + LN_EPS) * g.astype(jnp.float32) + b.astype(jnp.float32)
    return y.astype(x.dtype)


def rotary(x):
    s, d = x.shape[-2], x.shape[-1]
    inv_freq = 1.0 / (ROPE_BASE ** (jnp.arange(0, d, 2, dtype=jnp.float32) / d))
    ang = jnp.arange(s, dtype=jnp.float32)[:, None] * inv_freq[None, :]
    cos, sin = jnp.cos(ang).astype(x.dtype), jnp.sin(ang).astype(x.dtype)
    x1, x2 = x[..., : d // 2], x[..., d // 2:]
    return jnp.concatenate([x1 * cos - x2 * sin, x1 * sin + x2 * cos], axis=-1)


def retention_mixer(x, w_in, w_out):
    b, s, _ = x.shape
    nc = s // CHUNK
    dt = x.dtype
    proj = x @ w_in
    q, k, v, g = jnp.split(proj, [D_MODEL, 2 * D_MODEL, 2 * D_MODEL + RET_V_WIDTH], axis=-1)
    q = q.reshape(b, s, RET_HEADS, RET_QK_DIM).transpose(0, 2, 1, 3)
    k = k.reshape(b, s, RET_HEADS, RET_QK_DIM).transpose(0, 2, 1, 3) * (RET_QK_DIM ** -0.5)
    v = v.reshape(b, s, RET_HEADS, RET_V_DIM).transpose(0, 2, 1, 3)
    q, k = rotary(q), rotary(k)
    log_g = jnp.log(1.0 - 2.0 ** (-5.0 - jnp.arange(RET_HEADS, dtype=jnp.float32)))
    idx = jnp.arange(CHUNK, dtype=jnp.float32)
    intra_decay = jnp.exp(log_g[:, None, None] * jnp.abs(idx[:, None] - idx[None, :])).astype(dt)
    q_decay = jnp.exp(log_g[:, None] * (idx + 1.0))[..., None].astype(dt)
    k_decay = jnp.exp(log_g[:, None] * (CHUNK - 1.0 - idx))[..., None].astype(dt)
    chunk_decay = jnp.exp(log_g * CHUNK)[:, None, None].astype(dt)

    def to_chunks(t):
        return t.reshape(b, RET_HEADS, nc, CHUNK, t.shape[-1]).transpose(2, 0, 1, 3, 4)

    def step(state, inp):
        qi, ki, vi = inp
        scores = jnp.einsum('bhnd,bhmd->bhnm', qi, ki) * intra_decay
        out = (jnp.einsum('bhnm,bhme->bhne', scores, vi)
               + jnp.einsum('bhnd,bhde->bhne', qi * q_decay, state))
        state = state * chunk_decay + jnp.einsum('bhmd,bhme->bhde', ki * k_decay, vi)
        return state, out

    state0 = jnp.zeros((b, RET_HEADS, RET_QK_DIM, RET_V_DIM), dt)
    _, oc = lax.scan(step, state0, (to_chunks(q), to_chunks(k), to_chunks(v)))
    o = oc.transpose(1, 0, 3, 2, 4).reshape(b, s, RET_HEADS, RET_V_DIM)
    of = o.astype(jnp.float32)
    mu = jnp.mean(of, axis=-1, keepdims=True)
    var = jnp.mean(jnp.square(of - mu), axis=-1, keepdims=True)
    o = ((of - mu) * lax.rsqrt(var + LN_EPS)).astype(dt).reshape(b, s, RET_V_WIDTH)
    return (jax.nn.silu(g) * o) @ w_out


def shared_kv(x, w_kv):
    b, s, _ = x.shape
    kv = x @ w_kv
    k, v = jnp.split(kv, 2, axis=-1)
    k = k.reshape(b, s, SB_HEADS, SB_HEAD_DIM).transpose(0, 2, 1, 3)
    v = v.reshape(b, s, SB_HEADS, SB_HEAD_DIM).transpose(0, 2, 1, 3)
    return k, v


def stick_breaking_mixer(x, k, v, w_q, w_out):
    b, s, _ = x.shape
    scale = SB_HEAD_DIM ** -0.5
    q = (x @ w_q).reshape(b, s, SB_HEADS, SB_HEAD_DIM).transpose(0, 2, 1, 3)
    outs = []
    for start in range(0, s, SB_QBLOCK):
        end = start + SB_QBLOCK
        qb = q[:, :, start:end]
        kb, vb = k[:, :, :end], v[:, :, :end]
        z = jnp.einsum('bhtd,bhsd->bhts', qb, kb).astype(jnp.float32) * scale
        causal = jnp.arange(end)[None, :] < jnp.arange(start, end)[:, None]
        log_keep = jnp.where(causal, jax.nn.log_sigmoid(-z), 0.0)
        between = lax.cumsum(log_keep, axis=3, reverse=True) - log_keep
        w = jnp.where(causal, jnp.exp(jax.nn.log_sigmoid(z) + between), 0.0)
        outs.append(jnp.einsum('bhts,bhsd->bhtd', w.astype(vb.dtype), vb))
    o = jnp.concatenate(outs, axis=2).transpose(0, 2, 1, 3).reshape(b, s, D_MODEL)
    return o @ w_out


def swiglu(x, w_in, w_out):
    gate, up = jnp.split(x @ w_in, 2, axis=-1)
    return (jax.nn.silu(gate) * up) @ w_out


def moe_swiglu(x, w_router, w_in, w_out):
    b, s, d = x.shape
    xt = x.reshape(b * s, d)
    logits = (xt @ w_router).astype(jnp.float32)
    top_val, top_idx = lax.top_k(logits, TOP_K)
    top_w = jax.nn.softmax(top_val, axis=-1)
    gates = jnp.sum(jax.nn.one_hot(top_idx, N_EXPERTS, dtype=jnp.float32) * top_w[..., None], axis=1)
    gates = gates.astype(x.dtype)
    y = jnp.zeros_like(xt)
    for e in range(N_EXPERTS):
        y = y + gates[:, e:e + 1] * swiglu(xt, w_in[e], w_out[e])
    return y.reshape(b, s, d)


def setup_inputs(seed: int = 0) -> dict:
    key = jax.random.key(seed)
    ks = jax.random.split(key, 20)
    f32 = jnp.float32
    beta = DEEPNORM_BETA

    def nrm(k, shape, fan_in, gain=1.0):
        return jax.random.normal(k, shape, f32) * (fan_in ** -0.5) * gain

    x = jax.random.normal(ks[0], (BATCH, SEQ, D_MODEL), f32)
    ret_w_in = jnp.concatenate([
        nrm(ks[1], (N_A_LAYERS, D_MODEL, 2 * D_MODEL), D_MODEL),
        nrm(ks[2], (N_A_LAYERS, D_MODEL, RET_V_WIDTH), D_MODEL, beta),
        nrm(ks[3], (N_A_LAYERS, D_MODEL, RET_V_WIDTH), D_MODEL),
    ], axis=-1)
    ret_w_out = nrm(ks[4], (N_A_LAYERS, RET_V_WIDTH, D_MODEL), RET_V_WIDTH, beta)
    sb_w_kv = jnp.concatenate([
        nrm(ks[5], (D_MODEL, D_MODEL), D_MODEL),
        nrm(ks[6], (D_MODEL, D_MODEL), D_MODEL, beta),
    ], axis=-1)
    sb_w_q = nrm(ks[7], (N_B_LAYERS, D_MODEL, D_MODEL), D_MODEL)
    sb_w_out = nrm(ks[8], (N_B_LAYERS, D_MODEL, D_MODEL), D_MODEL, beta)
    ln_mix_g = 1.0 + 0.02 * jax.random.normal(ks[9], (DEPTH, D_MODEL), f32)
    ln_mix_b = 0.02 * jax.random.normal(ks[10], (DEPTH, D_MODEL), f32)
    ln_ffn_g = 1.0 + 0.02 * jax.random.normal(ks[11], (DEPTH, D_MODEL), f32)
    ln_ffn_b = 0.02 * jax.random.normal(ks[12], (DEPTH, D_MODEL), f32)
    ffn_w_in = nrm(ks[13], (N_DENSE_FFN, D_MODEL, 2 * D_FF), D_MODEL, beta)
    ffn_w_out = nrm(ks[14], (N_DENSE_FFN, D_FF, D_MODEL), D_FF, beta)
    moe_w_router = nrm(ks[15], (N_MOE_FFN, D_MODEL, N_EXPERTS), D_MODEL)
    moe_w_in = nrm(ks[16], (N_MOE_FFN, N_EXPERTS, D_MODEL, 2 * D_EXPERT), D_MODEL, beta)
    moe_w_out = nrm(ks[17], (N_MOE_FFN, N_EXPERTS, D_EXPERT, D_MODEL), D_EXPERT, beta)
    return {"x": x, "ret_w_in": ret_w_in, "ret_w_out": ret_w_out, "sb_w_kv": sb_w_kv,
            "sb_w_q": sb_w_q, "sb_w_out": sb_w_out, "ln_mix_g": ln_mix_g, "ln_mix_b": ln_mix_b,
            "ln_ffn_g": ln_ffn_g, "ln_ffn_b": ln_ffn_b, "ffn_w_in": ffn_w_in, "ffn_w_out": ffn_w_out,
            "moe_w_router": moe_w_router, "moe_w_in": moe_w_in, "moe_w_out": moe_w_out}


def reference(x, ret_w_in, ret_w_out, sb_w_kv, sb_w_q, sb_w_out, ln_mix_g, ln_mix_b,
              ln_ffn_g, ln_ffn_b, ffn_w_in, ffn_w_out, moe_w_router, moe_w_in, moe_w_out):
    shared_k = None
    shared_v = None
    for layer in range(DEPTH):
        if layer < N_A_LAYERS:
            mix = retention_mixer(x, ret_w_in[layer], ret_w_out[layer])
        else:
            j = layer - N_A_LAYERS
            mix = stick_breaking_mixer(x, shared_k, shared_v, sb_w_q[j], sb_w_out[j])
        x = layer_norm(DEEPNORM_ALPHA * x + mix, ln_mix_g[layer], ln_mix_b[layer])
        if layer % 2 == 0:
            f = swiglu(x, ffn_w_in[layer // 2], ffn_w_out[layer // 2])
        else:
            f = moe_swiglu(x, moe_w_router[layer // 2], moe_w_in[layer // 2], moe_w_out[layer // 2])
        x = layer_norm(DEEPNORM_ALPHA * x + f, ln_ffn_g[layer], ln_ffn_b[layer])
        if layer == N_A_LAYERS - 1:
            shared_k, shared_v = shared_kv(x, sb_w_kv)
    return x
```

```cpp
#include <hip/hip_runtime.h>
#include <hip/hip_cooperative_groups.h>
#include <cstdio>
#include <cstdint>
namespace cg = cooperative_groups;
namespace pg8 {
#define PG8_LAS __attribute__((address_space(3)))
typedef unsigned short bf16_t;
typedef short bf16x8 __attribute__((ext_vector_type(8)));
typedef float f32x4 __attribute__((ext_vector_type(4)));
typedef unsigned u32x4 __attribute__((ext_vector_type(4)));
typedef unsigned u32x2 __attribute__((ext_vector_type(2)));
typedef int v4i_t __attribute__((ext_vector_type(4)));
typedef int v8i_t __attribute__((ext_vector_type(8)));
constexpr int BM = 256, BK = 64, HALF = 128, HTB = HALF * BK * 2  , STAGE_BYTES = 8 * HTB, NXCD = 8;
#ifndef WGM_DEFAULT
#define WGM_DEFAULT 2
#endif
#ifndef WGM_T
#define WGM_T 4
#endif

__host__ __device__ __forceinline__ int lds_byte(int r, int c) { const int st = (r >> 4) * 2 + (c >> 5), rr = r & 15, cc = c & 31, ob = rr * 64 + cc * 2; return st * 1024 + (ob ^ (((ob >> 9) & 1) << 5)); }
__host__ __device__ __forceinline__ void stage_rc(int b, int& R, int& C) { const int st = b / 1024, sb = b % 1024, swz = sb ^ (((sb >> 9) & 1) << 5); R = (st >> 1) * 16 + swz / 64; C = (st & 1) * 32 + (swz % 64) / 2; }
__host__ __device__ __forceinline__ int perm32(int rho) { const int n = rho >> 4, i = rho & 15; return 8 * (i >> 2) + 4 * n + (i & 3); }

struct Unit { int pm, pn; };
struct Gemm { const bf16_t* A; const bf16_t* Bt; int M, N, K; };

struct StaticOrder {
    int nM, nN, nwg, G, c, wgm;
    __host__ __device__ void init(int M, int N, int G_, int c_, int wgm_ = WGM_DEFAULT) { nM = M / BM; nN = N / BM; nwg = nM * nN; G = G_; c = c_; wgm = wgm_; }
    __host__ __device__ bool next(int i, Unit& u) const {
        const long L = (long)i * G + c; if (L >= nwg) return false;
        int wgid = (int)L; { const int q = nwg / NXCD, r = nwg % NXCD, xcd = wgid % NXCD, off = wgid / NXCD; wgid = (xcd < r ? xcd * (q + 1) : r * (q + 1) + (xcd - r) * q) + off; }
        const int nig = wgm * nN, gid = wgid / nig, fm = gid * wgm, gsz = (nM - fm) < wgm ? (nM - fm) : wgm;
        u.pm = fm + ((wgid % nig) % gsz); u.pn = (wgid % nig) / gsz; return true;
    }
    __device__ __forceinline__ void a_ready(const Unit&) const {}
    __device__ __forceinline__ void done(const Unit&) const {}
};

__device__ __forceinline__ float sat8(float v) { return __builtin_amdgcn_fmed3f(v, -448.0f, 448.0f); }
typedef float f32x2_t __attribute__((ext_vector_type(2)));
typedef __bf16 bf16x2_t __attribute__((ext_vector_type(2)));
__device__ __forceinline__ unsigned cvt_pk_bf16(float lo, float hi) { const f32x2_t v = {lo, hi}; const bf16x2_t b = __builtin_convertvector(v, bf16x2_t); return __builtin_bit_cast(unsigned, b); }

struct MoeOrder : StaticOrder {
    const int* tile_e; int NT;
    __device__ __forceinline__ bool next(int i, Unit& u) const {
        if (!StaticOrder::next(i, u)) return false;
        const int e = __builtin_amdgcn_readfirstlane(__hip_atomic_load(tile_e + u.pm, __ATOMIC_RELAXED, __HIP_MEMORY_SCOPE_AGENT));
        u.pn += e * NT; return true;
    }
};

struct EpiBf16Plain {
    static constexpr bool PERM = true, AFTER_DRAIN = false;
    bf16_t* O; int ldc; float sc; int ntmod;
    __device__ __forceinline__ void operator()(const f32x4 (&acc)[2][2][4][2], const Unit& u, int wr, int wc, int fr, int fq) const {
        const int row0 = u.pm * BM + wr * 64 + fr, col0 = (ntmod ? (u.pn % ntmod) : u.pn) * BM + wc * 32 + 8 * fq; const float scl = sc != 0.f ? sc : 1.0f;
#pragma unroll
        for (int ai = 0; ai < 2; ++ai)
#pragma unroll
            for (int m = 0; m < 4; ++m) { bf16_t* rowp = O + (size_t)(row0 + ai * HALF + m * 16) * ldc + col0;
#pragma unroll
                for (int bj = 0; bj < 2; ++bj) { const f32x4 v0 = acc[ai][bj][m][0] * scl, v1 = acc[ai][bj][m][1] * scl;
                    u32x4 w; w.x = cvt_pk_bf16(v0[0], v0[1]); w.y = cvt_pk_bf16(v0[2], v0[3]); w.z = cvt_pk_bf16(v1[0], v1[1]); w.w = cvt_pk_bf16(v1[2], v1[3]);
                    *(u32x4*)(rowp + bj * HALF) = w; } }
    }
};
struct EpiRetNat {
    static constexpr bool PERM = true, AFTER_DRAIN = false;
    bf16_t* QK; bf16_t* Gt; const float* cosN; const float* sinN; const float* kd;
    __device__ __forceinline__ void operator()(const f32x4 (&acc)[2][2][4][2], const Unit& u, int wr, int wc, int fr, int fq) const {
        const int row0 = u.pm * BM + wr * 64 + fr;
        if (u.pn >= 8) {
            const int col0 = (u.pn - 8) * BM + wc * 32 + 8 * fq;
#pragma unroll
            for (int ai = 0; ai < 2; ++ai)
#pragma unroll
                for (int m = 0; m < 4; ++m) { bf16_t* rowp = Gt + (size_t)(row0 + ai * HALF + m * 16) * 2048 + col0;
#pragma unroll
                    for (int bj = 0; bj < 2; ++bj) { const f32x4 v0 = acc[ai][bj][m][0], v1 = acc[ai][bj][m][1];
                        u32x4 w; w.x = cvt_pk_bf16(v0[0], v0[1]); w.y = cvt_pk_bf16(v0[2], v0[3]); w.z = cvt_pk_bf16(v1[0], v1[1]); w.w = cvt_pk_bf16(v1[2], v1[3]);
                        *(u32x4*)(rowp + bj * HALF) = w; } }
        } else {
            const int dcol = wc * 32 + 8 * fq;
#pragma unroll
            for (int ai = 0; ai < 2; ++ai)
#pragma unroll
                for (int m = 0; m < 4; ++m) { const int r = row0 + ai * HALF + m * 16, pos = r & 4095;
                    const float* cp = cosN + pos * 128 + dcol; const float* sp = sinN + pos * 128 + dcol;
                    const f32x4 c0 = *(const f32x4*)cp, c1 = *(const f32x4*)(cp + 4), s0 = *(const f32x4*)sp, s1 = *(const f32x4*)(sp + 4);
                    const f32x4 a0 = acc[ai][0][m][0], a1 = acc[ai][0][m][1], b0 = acc[ai][1][m][0], b1 = acc[ai][1][m][1];
                    const float kdv = (u.pn >= 4) ? kd[(u.pn - 4) * 64 + (pos & 63)] : 1.0f;
                    const f32x4 o10 = (a0 * c0 - b0 * s0) * kdv, o11 = (a1 * c1 - b1 * s1) * kdv, o20 = (a0 * s0 + b0 * c0) * kdv, o21 = (a1 * s1 + b1 * c1) * kdv;
                    bf16_t* rowp = QK + (size_t)r * 2048 + u.pn * BM + dcol;
                    u32x4 w; w.x = cvt_pk_bf16(o10[0], o10[1]); w.y = cvt_pk_bf16(o10[2], o10[3]); w.z = cvt_pk_bf16(o11[0], o11[1]); w.w = cvt_pk_bf16(o11[2], o11[3]);
                    *(u32x4*)rowp = w;
                    w.x = cvt_pk_bf16(o20[0], o20[1]); w.y = cvt_pk_bf16(o20[2], o20[3]); w.z = cvt_pk_bf16(o21[0], o21[1]); w.w = cvt_pk_bf16(o21[2], o21[3]);
                    *(u32x4*)(rowp + HALF) = w; }
        }
    }
};
struct EpiRetT {
    static constexpr bool PERM = true, AFTER_DRAIN = false;
    bf16_t* KVT; const float* cosT; const float* sinT; const float* kd;
    __device__ __forceinline__ void operator()(const f32x4 (&acc)[2][2][4][2], const Unit& u, int wr, int wc, int fr, int fq) const {
        const int col0 = u.pn * BM + wc * 32 + 8 * fq;
        if (u.pm >= 4) {
            const int row0 = u.pm * BM + wr * 64 + fr;
#pragma unroll
            for (int ai = 0; ai < 2; ++ai)
#pragma unroll
                for (int m = 0; m < 4; ++m) { bf16_t* rowp = KVT + (size_t)(row0 + ai * HALF + m * 16) * 16384 + col0;
#pragma unroll
                    for (int bj = 0; bj < 2; ++bj) { const f32x4 v0 = acc[ai][bj][m][0], v1 = acc[ai][bj][m][1];
                        u32x4 w; w.x = cvt_pk_bf16(v0[0], v0[1]); w.y = cvt_pk_bf16(v0[2], v0[3]); w.z = cvt_pk_bf16(v1[0], v1[1]); w.w = cvt_pk_bf16(v1[2], v1[3]);
                        *(u32x4*)(rowp + bj * HALF) = w; } }
        } else {
            const int h = u.pm;
#pragma unroll
            for (int m = 0; m < 4; ++m) { const int d = wr * 64 + m * 16 + fr;
#pragma unroll
                for (int bj = 0; bj < 2; ++bj) { const int c = col0 + bj * HALF, pos = c & 4095;
                    const float* cp = cosT + d * 4096 + pos; const float* sp = sinT + d * 4096 + pos; const float* kp = kd + h * 64 + (pos & 63);
                    const f32x4 c0 = *(const f32x4*)cp, c1 = *(const f32x4*)(cp + 4), s0 = *(const f32x4*)sp, s1 = *(const f32x4*)(sp + 4), k0 = *(const f32x4*)kp, k1 = *(const f32x4*)(kp + 4);
                    const f32x4 a0 = acc[0][bj][m][0], a1 = acc[0][bj][m][1], b0 = acc[1][bj][m][0], b1 = acc[1][bj][m][1];
                    const f32x4 o10 = (a0 * c0 - b0 * s0) * k0, o11 = (a1 * c1 - b1 * s1) * k1, o20 = (a0 * s0 + b0 * c0) * k0, o21 = (a1 * s1 + b1 * c1) * k1;
                    bf16_t* rowp = KVT + (size_t)(h * 256 + d) * 16384 + c;
                    u32x4 w; w.x = cvt_pk_bf16(o10[0], o10[1]); w.y = cvt_pk_bf16(o10[2], o10[3]); w.z = cvt_pk_bf16(o11[0], o11[1]); w.w = cvt_pk_bf16(o11[2], o11[3]);
                    *(u32x4*)rowp = w;
                    w.x = cvt_pk_bf16(o20[0], o20[1]); w.y = cvt_pk_bf16(o20[2], o20[3]); w.z = cvt_pk_bf16(o21[0], o21[1]); w.w = cvt_pk_bf16(o21[2], o21[3]);
                    *(u32x4*)(rowp + (size_t)HALF * 16384) = w; } }
        }
    }
};
struct EpiResF32 {
    static constexpr bool PERM = false, AFTER_DRAIN = false;
    const float* res; float* out; int ldc; float alpha; int ntmod; float sc;
    __device__ __forceinline__ void operator()(const f32x4 (&acc)[2][2][4][2], const Unit& u, int wr, int wc, int fr, int fq) const {
        const int pnl = ntmod ? (u.pn % ntmod) : u.pn;
        const int row0 = u.pm * BM + wr * 64 + fr, col0 = pnl * BM + wc * 32 + 4 * fq;
#pragma unroll
        for (int ai = 0; ai < 2; ++ai)
#pragma unroll
            for (int mp = 0; mp < 2; ++mp) {
                f32x4 rv[2][2][2];
                if (res) {
#pragma unroll
                    for (int mm = 0; mm < 2; ++mm) { const size_t off = (size_t)(row0 + ai * HALF + (2 * mp + mm) * 16) * ldc + col0;
#pragma unroll
                        for (int bj = 0; bj < 2; ++bj)
#pragma unroll
                            for (int n = 0; n < 2; ++n) rv[mm][bj][n] = *(const f32x4*)(res + off + bj * HALF + n * 16); }
                }
#pragma unroll
                for (int mm = 0; mm < 2; ++mm) { const int m = 2 * mp + mm; const size_t off = (size_t)(row0 + ai * HALF + m * 16) * ldc + col0;
#pragma unroll
                    for (int bj = 0; bj < 2; ++bj)
#pragma unroll
                        for (int n = 0; n < 2; ++n) { f32x4 o = acc[ai][bj][m][n] * sc;
                            if (res) o = o + rv[mm][bj][n] * alpha;
                            *(f32x4*)(out + off + bj * HALF + n * 16) = o; } }
                asm volatile("" ::: "memory");
            }
    }
};
struct EpiSwiglu {
    static constexpr bool PERM = true, AFTER_DRAIN = false;
    bf16_t* O; int ldc; int ntmod; float sc;
    float osc;
    __device__ __forceinline__ void operator()(const f32x4 (&acc)[2][2][4][2], const Unit& u, int wr, int wc, int fr, int fq) const {
        typedef float f32x2v __attribute__((ext_vector_type(2)));
        const int pnl = ntmod ? (u.pn % ntmod) : u.pn;
        const int row0 = u.pm * BM + wr * 64 + fr, col0 = pnl * HALF + wc * 32 + 8 * fq;
        const float c1 = -sc * 1.4426950408889634f, c2 = sc * sc * (osc != 0.f ? osc : 1.0f);
#pragma unroll
        for (int ai = 0; ai < 2; ++ai)
#pragma unroll
            for (int m = 0; m < 4; ++m) {
                f32x2v hv[2][2];
#pragma unroll
                for (int n = 0; n < 2; ++n) { const f32x4 g = acc[ai][0][m][n], up = acc[ai][1][m][n];
#pragma unroll
                    for (int jp = 0; jp < 2; ++jp) { const f32x2v g2 = (f32x2v){g[2 * jp], g[2 * jp + 1]}, u2 = (f32x2v){up[2 * jp], up[2 * jp + 1]};
                        const f32x2v a = g2 * c1; f32x2v t; t.x = __builtin_amdgcn_exp2f(a.x); t.y = __builtin_amdgcn_exp2f(a.y);
                        const f32x2v d = t + 1.0f; f32x2v r; r.x = __builtin_amdgcn_rcpf(d.x); r.y = __builtin_amdgcn_rcpf(d.y);
                        hv[n][jp] = ((g2 * u2) * r) * c2; } }
                if (osc != 0.f) { u32x2 w8;
                    int t0 = __builtin_amdgcn_cvt_pk_fp8_f32(sat8(hv[0][0].x), sat8(hv[0][0].y), 0, false); t0 = __builtin_amdgcn_cvt_pk_fp8_f32(sat8(hv[0][1].x), sat8(hv[0][1].y), t0, true);
                    int t1 = __builtin_amdgcn_cvt_pk_fp8_f32(sat8(hv[1][0].x), sat8(hv[1][0].y), 0, false); t1 = __builtin_amdgcn_cvt_pk_fp8_f32(sat8(hv[1][1].x), sat8(hv[1][1].y), t1, true);
                    w8.x = (unsigned)t0; w8.y = (unsigned)t1; *(u32x2*)((unsigned char*)O + (size_t)(row0 + ai * HALF + m * 16) * ldc + col0) = w8; }
                else { bf16_t* rowp = O + (size_t)(row0 + ai * HALF + m * 16) * ldc + col0;
                    u32x4 w; w.x = cvt_pk_bf16(hv[0][0].x, hv[0][0].y); w.y = cvt_pk_bf16(hv[0][1].x, hv[0][1].y); w.z = cvt_pk_bf16(hv[1][0].x, hv[1][0].y); w.w = cvt_pk_bf16(hv[1][1].x, hv[1][1].y);
                    *(u32x4*)rowp = w; }
            }
    }
};

template <class Epi, class Sched, bool ALIGN_EPI = false, bool SP2 = false, bool FP8 = false>
__device__ __forceinline__ void gemm_phase(PG8_LAS unsigned char* lds, const Gemm g, const Sched& S, const Epi& E) {
    int tid_ = threadIdx.x; asm volatile("" : "+v"(tid_));
    const int tid = tid_, wid = __builtin_amdgcn_readfirstlane(tid >> 6), lane = tid & 63, wr = wid >> 2, wc = wid & 3, fr = lane & 15, fq = lane >> 4;
    const int K = g.K, Kb = FP8 ? K : 2 * K, nt = Kb / 128;
    unsigned voffA[2], voffB[2];
#pragma unroll
    for (int i = 0; i < 2; ++i) { int R, C; stage_rc(tid * 16 + i * 8192, R, C); const int Rb = Epi::PERM ? ((R & ~31) + perm32(R & 31)) : R;
        voffA[i] = (unsigned)(R * Kb + 2 * C); voffB[i] = (unsigned)(Rb * Kb + 2 * C); }
    const size_t kstep = (size_t)(BK * 2);
    const size_t hstep = (size_t)HALF * Kb;
    const size_t tstep = 2 * hstep;
    const unsigned ldsw = (unsigned)wid * 1024u;
    const int aoff = FP8 ? lds_byte(wr * 64 + fr, fq * 16) : lds_byte(wr * 64 + fr, fq * 8), boff = FP8 ? lds_byte(wc * 32 + fr, fq * 16) : lds_byte(wc * 32 + fr, fq * 8);
    int abase = aoff, bbase = boff + 4 * HTB; asm volatile("" : "+v"(abase), "+v"(bbase));
    constexpr int PIECE = FP8 ? 16 : 1024;
#define PG8_SA(b, h) (((b) * 2 + (h)) * HTB)
#define PG8_SB(b, h) ((4 + (b) * 2 + (h)) * HTB)
#define PG8_STAGE(bufoff, gbase, voff) do { _Pragma("unroll") for (int _i = 0; _i < 2; ++_i) \
        __builtin_amdgcn_global_load_lds((const unsigned*)((const char*)(gbase) + (voff)[_i]), (PG8_LAS unsigned*)(lds + (bufoff) + ldsw + _i * 8192), 16, 0, 0); } while (0)
#define PG8_LDA(dst, b, h) do { _Pragma("unroll") for (int m = 0; m < 4; ++m) _Pragma("unroll") for (int k = 0; k < 2; ++k) dst[m][k] = *(const PG8_LAS bf16x8*)(lds + abase + (PG8_SA(b, h) + m * 2048 + k * PIECE)); } while (0)
#define PG8_LDB(dst, b, h) do { _Pragma("unroll") for (int n = 0; n < 2; ++n) _Pragma("unroll") for (int k = 0; k < 2; ++k) dst[n][k] = *(const PG8_LAS bf16x8*)(lds + bbase + (PG8_SB(b, h) - 4 * HTB + n * 2048 + k * PIECE)); } while (0)
#define PG8_MMA(ai, bj, At, Bt) do { __builtin_amdgcn_s_setprio(1); _Pragma("unroll") for (int m = 0; m < 4; ++m) _Pragma("unroll") for (int n = 0; n < 2; ++n) { \
        if constexpr (FP8) { const v8i_t a_ = __builtin_shufflevector(__builtin_bit_cast(v4i_t, At[m][0]), __builtin_bit_cast(v4i_t, At[m][1]), 0, 1, 2, 3, 4, 5, 6, 7), b_ = __builtin_shufflevector(__builtin_bit_cast(v4i_t, Bt[n][0]), __builtin_bit_cast(v4i_t, Bt[n][1]), 0, 1, 2, 3, 4, 5, 6, 7); \
            asm volatile("v_mfma_f32_16x16x128_f8f6f4 %0, %1, %2, %0" : "+v"(acc[ai][bj][m][n]) : "v"(b_), "v"(a_)); } \
        else { _Pragma("unroll") for (int k = 0; k < 2; ++k) acc[ai][bj][m][n] = __builtin_amdgcn_mfma_f32_16x16x32_bf16(Bt[n][k], At[m][k], acc[ai][bj][m][n], 0, 0, 0); } } \
        __builtin_amdgcn_s_setprio(0); } while (0)
#define PG8_WAIT_V(n) asm volatile("s_waitcnt vmcnt(" #n ")" ::: "memory")
#define PG8_WAIT_L(n) asm volatile("s_waitcnt lgkmcnt(" #n ")" ::: "memory")
#define PG8_BAR __builtin_amdgcn_s_barrier()
#define PG8_SCHED __builtin_amdgcn_sched_barrier(0)
    Unit cur, nxt; int ui = 0;
    if (!S.next(0, cur)) return;
    f32x4 acc[2][2][4][2];
#pragma unroll
    for (int a = 0; a < 2; ++a)
#pragma unroll
        for (int b = 0; b < 2; ++b)
#pragma unroll
            for (int m = 0; m < 4; ++m)
#pragma unroll
                for (int n = 0; n < 2; ++n) acc[a][b][m][n] = (f32x4){0.f, 0.f, 0.f, 0.f};
    bf16x8 At[4][2], B0[2][2], B1[2][2];
    const char* cA = (const char*)g.A + (size_t)cur.pm * tstep; const char* cB = (const char*)g.Bt + (size_t)cur.pn * tstep;
    S.a_ready(cur);
    if constexpr (SP2) {
        PG8_STAGE(PG8_SB(0, 0), cB, voffB); PG8_STAGE(PG8_SB(0, 1), cB + hstep, voffB); PG8_STAGE(PG8_SA(0, 0), cA, voffA); PG8_STAGE(PG8_SA(0, 1), cA + hstep, voffA);
        if (wr == 1) PG8_BAR;
        PG8_WAIT_V(2); PG8_BAR;
        PG8_STAGE(PG8_SB(1, 0), cB + kstep, voffB); PG8_STAGE(PG8_SA(1, 0), cA + kstep, voffA); PG8_STAGE(PG8_SB(1, 1), cB + hstep + kstep, voffB);
        PG8_WAIT_V(6); PG8_BAR;
    } else {
        PG8_STAGE(PG8_SB(0, 0), cB, voffB); PG8_STAGE(PG8_SA(0, 0), cA, voffA); PG8_STAGE(PG8_SB(0, 1), cB + hstep, voffB); PG8_STAGE(PG8_SA(0, 1), cA + hstep, voffA);
        if (wr == 1) PG8_BAR;
        PG8_WAIT_V(4); PG8_BAR;
        PG8_STAGE(PG8_SB(1, 0), cB + kstep, voffB); PG8_STAGE(PG8_SA(1, 0), cA + kstep, voffA); PG8_STAGE(PG8_SB(1, 1), cB + hstep + kstep, voffB);
        PG8_WAIT_V(6); PG8_BAR;
    }
    for (;;) {
        const bool has_next = S.next(ui + 1, nxt);
        const char* nA = has_next ? (const char*)g.A + (size_t)nxt.pm * tstep : cA; const char* nB = has_next ? (const char*)g.Bt + (size_t)nxt.pn * tstep : cB;
#pragma nounroll
        for (int t = 0; t < nt; t += 2) {
            const bool last = (t == nt - 2);
            asm volatile("" : "+v"(voffA[0]), "+v"(voffA[1]), "+v"(voffB[0]), "+v"(voffB[1]));
            const char* a1 = cA + (size_t)(t + 1) * kstep;
            const char* a2 = last ? nA : cA + (size_t)(t + 2) * kstep; const char* b2 = last ? nB : cB + (size_t)(t + 2) * kstep;
            const char* a3 = a2 + kstep; const char* b3 = b2 + kstep;
            if (last && has_next) S.a_ready(nxt);
            if constexpr (SP2) {
            PG8_LDB(B0, 0, 0); PG8_LDB(B1, 0, 1); PG8_SCHED; PG8_LDA(At, 0, 0); PG8_STAGE(PG8_SA(1, 1), a1 + hstep, voffA);
            PG8_WAIT_V(8); PG8_WAIT_L(0); PG8_BAR; PG8_MMA(0, 0, At, B0); PG8_MMA(0, 1, At, B1); PG8_BAR; PG8_SCHED;
            PG8_LDA(At, 0, 1); PG8_STAGE(PG8_SB(0, 0), b2, voffB); PG8_STAGE(PG8_SB(0, 1), b2 + hstep, voffB); PG8_STAGE(PG8_SA(0, 0), a2, voffA);
            PG8_WAIT_V(8); PG8_WAIT_L(0); PG8_BAR; PG8_MMA(1, 0, At, B0); PG8_MMA(1, 1, At, B1); PG8_BAR; PG8_SCHED;
            PG8_LDB(B0, 1, 0); PG8_LDB(B1, 1, 1); PG8_SCHED; PG8_LDA(At, 1, 0); PG8_STAGE(PG8_SA(0, 1), a2 + hstep, voffA);
            PG8_WAIT_V(8); PG8_WAIT_L(0); PG8_BAR; PG8_MMA(0, 0, At, B0); PG8_MMA(0, 1, At, B1); PG8_BAR; PG8_SCHED;
            PG8_LDA(At, 1, 1); PG8_STAGE(PG8_SB(1, 0), b3, voffB); PG8_STAGE(PG8_SB(1, 1), b3 + hstep, voffB); PG8_STAGE(PG8_SA(1, 0), a3, voffA);
            PG8_WAIT_V(8); PG8_WAIT_L(0); PG8_BAR; PG8_MMA(1, 0, At, B0); PG8_MMA(1, 1, At, B1); PG8_BAR; PG8_SCHED;
            } else {
            PG8_LDB(B0, 0, 0); PG8_SCHED; PG8_LDA(At, 0, 0); PG8_STAGE(PG8_SA(1, 1), a1 + hstep, voffA);
            PG8_WAIT_L(8); PG8_BAR; PG8_WAIT_L(0); PG8_MMA(0, 0, At, B0); PG8_BAR; PG8_SCHED;
            PG8_LDB(B1, 0, 1); PG8_STAGE(PG8_SB(0, 0), b2, voffB);
            PG8_BAR; PG8_WAIT_L(0); PG8_MMA(0, 1, At, B1); PG8_BAR;
            PG8_LDA(At, 0, 1); PG8_STAGE(PG8_SA(0, 0), a2, voffA);
            PG8_BAR; PG8_WAIT_L(0); PG8_MMA(1, 0, At, B0); PG8_BAR; PG8_SCHED;
            PG8_STAGE(PG8_SB(0, 1), b2 + hstep, voffB);
            PG8_WAIT_V(6); PG8_BAR; PG8_MMA(1, 1, At, B1); PG8_BAR;
            PG8_LDB(B0, 1, 0); PG8_SCHED; PG8_LDA(At, 1, 0); PG8_STAGE(PG8_SA(0, 1), a2 + hstep, voffA);
            PG8_WAIT_L(8); PG8_BAR; PG8_WAIT_L(0); PG8_MMA(0, 0, At, B0); PG8_BAR; PG8_SCHED;
            PG8_LDB(B1, 1, 1); PG8_STAGE(PG8_SB(1, 0), b3, voffB);
            PG8_BAR; PG8_WAIT_L(0); PG8_MMA(0, 1, At, B1); PG8_BAR;
            PG8_LDA(At, 1, 1); PG8_STAGE(PG8_SA(1, 0), a3, voffA);
            PG8_BAR; PG8_WAIT_L(0); PG8_MMA(1, 0, At, B0); PG8_BAR; PG8_SCHED;
            PG8_STAGE(PG8_SB(1, 1), b3 + hstep, voffB);
            PG8_WAIT_V(6); PG8_BAR; PG8_MMA(1, 1, At, B1); PG8_BAR;
            }
        }
        if constexpr (FP8) asm volatile("s_nop 15\n\ts_nop 15" ::: "memory");
        if constexpr (ALIGN_EPI) { if (wr == 0) PG8_BAR; }
        if constexpr (!Epi::AFTER_DRAIN) { E(acc, cur, wr, wc, fr, fq); S.done(cur); }
        if (!has_next) break;
#pragma unroll
        for (int a = 0; a < 2; ++a)
#pragma unroll
            for (int b = 0; b < 2; ++b)
#pragma unroll
                for (int m = 0; m < 4; ++m)
#pragma unroll
                    for (int n = 0; n < 2; ++n) acc[a][b][m][n] = (f32x4){0.f, 0.f, 0.f, 0.f};
        cur = nxt; cA = nA; cB = nB; ++ui;
        if constexpr (ALIGN_EPI) { if (wr == 1) PG8_BAR; }
    }
    PG8_WAIT_V(0);
    if constexpr (!ALIGN_EPI) { if (wr == 0) PG8_BAR; }
    PG8_BAR;
    if constexpr (Epi::AFTER_DRAIN) { E.fused(acc, cur, wr, wc, fr, fq, lds, wid, lane); S.done(cur); }
#undef PG8_SA
#undef PG8_SB
#undef PG8_STAGE
#undef PG8_LDA
#undef PG8_LDB
#undef PG8_MMA
#undef PG8_WAIT_V
#undef PG8_WAIT_L
#undef PG8_BAR
#undef PG8_SCHED
}
}


#define LAS __attribute__((address_space(3)))
typedef unsigned short bf16;
typedef unsigned u32x4 __attribute__((ext_vector_type(4)));
typedef unsigned u32x2 __attribute__((ext_vector_type(2)));
typedef float f32x4 __attribute__((ext_vector_type(4)));
typedef short bf16x8 __attribute__((ext_vector_type(8)));
typedef short s16x4_t __attribute__((ext_vector_type(4)));
using pg8::cvt_pk_bf16;

constexpr int NTOK = 16384, DM = 1024, SEQ = 4096;
constexpr int DFF = 2816, DEXP = 3584, NEXP = 8;
constexpr float ALPHA = 1.4142135623730951f;
constexpr float LN_EPS = 1e-5f;
constexpr int RMAX = 32768 + 8 * 256;
constexpr int LDS_BYTES = 143360;
constexpr float W6_SCALE = 32.0f, W7_SCALE = 64.0f, H_SCALE = 16.0f;
constexpr float W14_SCALE = 64.0f, H2_SCALE = 16.0f;
constexpr float W13_SCALE = 32.0f;

constexpr size_t MiB = 1u << 20;
constexpr size_t WS_CTL = 0;
constexpr size_t WS_ROPE = 1 * MiB;
constexpr size_t WS_ROUTE = 9 * MiB;
constexpr size_t WS_W1A = 16 * MiB, WS_W1B = 24 * MiB, WS_W4 = 30 * MiB, WS_W9A = 34 * MiB, WS_W9B = 38 * MiB, WS_W11 = 40 * MiB,
                 WS_W6 = 42 * MiB, WS_W7 = 53 * MiB, WS_W13 = 59 * MiB, WS_W14 = 171 * MiB;
constexpr size_t WS_XB = 228 * MiB, WS_XF = 260 * MiB, WS_Y = 324 * MiB, WS_RA = 388 * MiB, WS_RB = 644 * MiB, WS_END = 788 * MiB;

__device__ __forceinline__ int opq(int v) { asm volatile("" : "+v"(v)); return v; }
__device__ __forceinline__ float wave_sum(float v) {
#pragma unroll
    for (int o = 1; o < 64; o <<= 1) v += __shfl_xor(v, o);
    return v;
}
__device__ __forceinline__ float bf2f(unsigned short b) { return __uint_as_float(((unsigned)b) << 16); }
__device__ __forceinline__ void unpack8(const u32x4 v, float* f) {
    f[0] = __uint_as_float(v.x << 16); f[1] = __uint_as_float(v.x & 0xffff0000u); f[2] = __uint_as_float(v.y << 16); f[3] = __uint_as_float(v.y & 0xffff0000u);
    f[4] = __uint_as_float(v.z << 16); f[5] = __uint_as_float(v.z & 0xffff0000u); f[6] = __uint_as_float(v.w << 16); f[7] = __uint_as_float(v.w & 0xffff0000u);
}

#define RLX_AGENT __ATOMIC_RELAXED, __HIP_MEMORY_SCOPE_AGENT
#define XB_TMO      128
#define XB_XCNT(j)  (256  + 64 * (j))
#define XB_XSUB(j)  (1280 + 64 * (j))
#define XB_XGEN(j)  (2304 + 64 * (j))
#define XB_TOP      3328
#define XB_TOPGEN   3392
#define XCD_BAR_WORDS 3456
#define XB_SPIN_CAP (1u << 18)

__device__ __forceinline__ unsigned xb_ld(unsigned* p)              { return __hip_atomic_load(p, __ATOMIC_RELAXED, __HIP_MEMORY_SCOPE_AGENT); }
__device__ __forceinline__ unsigned xb_add(unsigned* p, unsigned v) { return __hip_atomic_fetch_add(p, v, __ATOMIC_RELAXED, __HIP_MEMORY_SCOPE_AGENT); }
__device__ __forceinline__ unsigned xb_xcc_id() { return (unsigned)__builtin_amdgcn_s_getreg((3 << 11) | 20) & 0xFu; }
#define XB_SPIN(cond, bar) do { unsigned _sp = 0; while (cond) { __builtin_amdgcn_s_sleep(1); \
    if ((++_sp & 255u) == 0u) { if (xb_ld(&(bar)[XB_TMO])) break; if (_sp > XB_SPIN_CAP) { atomicAdd(&(bar)[XB_TMO], 1u); break; } } } } while (0)

struct XcdBarrier {
    unsigned* bar; unsigned x;
    volatile LAS unsigned* st;
};

__device__ __forceinline__ XcdBarrier xcd_barrier_post(unsigned* bar, volatile LAS unsigned* st) {
    XcdBarrier b; b.bar = bar; b.x = xb_xcc_id(); b.st = st;
    if (threadIdx.x == 0) (void)xb_add(&bar[XB_XCNT(b.x)], 1u);
    return b;
}
__device__ __forceinline__ void xcd_barrier_complete(unsigned* bar, unsigned x, unsigned& nloc, unsigned& nx) {
    const unsigned G = gridDim.x * gridDim.y * gridDim.z;
    unsigned sum, cnt, mine, sp = 0u;
    for (;;) {
        sum = 0u; cnt = 0u; mine = 0u;
#pragma unroll
        for (unsigned j = 0; j < 16; ++j) { const unsigned c = xb_ld(&bar[XB_XCNT(j)]); sum += c; cnt += (c > 0u) ? 1u : 0u; mine = (j == x) ? c : mine; }
        if (sum == G) break;
        __builtin_amdgcn_s_sleep(1);
        if ((++sp & 255u) == 0u) { if (xb_ld(&bar[XB_TMO])) break; if (sp > XB_SPIN_CAP) { atomicAdd(&bar[XB_TMO], 1u); break; } }
    }
    nloc = mine > 0u ? mine : 1u; nx = cnt > 0u ? cnt : 1u;
}

__device__ __forceinline__ void xcd_barrier(const XcdBarrier& b) {
    asm volatile("s_waitcnt vmcnt(0)" ::: "memory");
    __syncthreads();
    if (threadIdx.x == 0) {
        unsigned* bar = b.bar;
        __builtin_amdgcn_s_waitcnt(0);
        unsigned nloc = b.st[0], nx = b.st[1];
        if (nloc == 0u) { xcd_barrier_complete(bar, b.x, nloc, nx); b.st[0] = nloc; b.st[1] = nx; }
        const unsigned old = xb_add(&bar[XB_XSUB(b.x)], 1u);
        const unsigned gen = old / nloc;
        if (old + 1u == (gen + 1u) * nloc) {
            __builtin_amdgcn_fence(__ATOMIC_RELEASE, "agent");
            asm volatile("s_waitcnt vmcnt(0)" ::: "memory");
            const unsigned og = xb_add(&bar[XB_TOP], 1u);
            const unsigned tg = og / nx;
            if (og + 1u == (tg + 1u) * nx) xb_add(&bar[XB_TOPGEN], 1u);
            else XB_SPIN(xb_ld(&bar[XB_TOPGEN]) == tg, bar);
            __builtin_amdgcn_fence(__ATOMIC_ACQUIRE, "agent");
            xb_add(&bar[XB_XGEN(b.x)], 1u);
            asm volatile("s_waitcnt vmcnt(0)" ::: "memory");
        } else {
            XB_SPIN(xb_ld(&bar[XB_XGEN(b.x)]) == gen, bar);
            __builtin_amdgcn_fence(__ATOMIC_ACQUIRE, "agent");
            asm volatile("s_waitcnt vmcnt(0)" ::: "memory");
        }
    }
    __syncthreads();
}


__device__ __forceinline__ void tr_tile(const float* W, int N, int K, bf16* d1, bf16* d2, float scale, LAS float* scr, int lane) {
    f32x4 v[16];
    const float* src = W + (size_t)(lane >> 4) * N + 4 * (lane & 15);
#pragma unroll
    for (int it = 0; it < 16; ++it) v[it] = __builtin_nontemporal_load((const f32x4*)(src + (size_t)(4 * it) * N));
#pragma unroll
    for (int it = 0; it < 16; ++it) { LAS float* p = scr + (4 * it + (lane >> 4)) * 65 + 4 * (lane & 15);
        p[0] = v[it][0] * scale; p[1] = v[it][1] * scale; p[2] = v[it][2] * scale; p[3] = v[it][3] * scale; }
    asm volatile("s_waitcnt lgkmcnt(0)" ::: "memory");
    const int c = lane & 7;
#pragma unroll
    for (int jj = 0; jj < 8; ++jj) { const int n = (lane >> 3) + 8 * jj; const LAS float* s = scr + (8 * c) * 65 + n;
        u32x4 o; o.x = cvt_pk_bf16(s[0], s[65]); o.y = cvt_pk_bf16(s[2 * 65], s[3 * 65]); o.z = cvt_pk_bf16(s[4 * 65], s[5 * 65]); o.w = cvt_pk_bf16(s[6 * 65], s[7 * 65]);
        *(u32x4*)(d1 + (size_t)n * K + 8 * c) = o;
        if (d2) *(u32x4*)(d2 + (size_t)n * K + 8 * c) = o; }
    asm volatile("s_waitcnt lgkmcnt(0)" ::: "memory");
}
__device__ __forceinline__ int swi_row(int n0, int F) { return n0 < F ? (n0 >> 7) * 256 + (n0 & 127) : ((n0 - F) >> 7) * 256 + 128 + ((n0 - F) & 127); }

__device__ __forceinline__ void tr_tile_f8(const float* W, int N, int K, unsigned char* d1, float scale, LAS float* scr, int lane) {
    f32x4 v[16];
    const float* src = W + (size_t)(lane >> 4) * N + 4 * (lane & 15);
#pragma unroll
    for (int it = 0; it < 16; ++it) v[it] = __builtin_nontemporal_load((const f32x4*)(src + (size_t)(4 * it) * N));
#pragma unroll
    for (int it = 0; it < 16; ++it) { LAS float* p = scr + (4 * it + (lane >> 4)) * 65 + 4 * (lane & 15);
        p[0] = v[it][0] * scale; p[1] = v[it][1] * scale; p[2] = v[it][2] * scale; p[3] = v[it][3] * scale; }
    asm volatile("s_waitcnt lgkmcnt(0)" ::: "memory");
    const int c = lane & 3;
#pragma unroll
    for (int jj = 0; jj < 4; ++jj) { const int n = (lane >> 2) + 16 * jj; const LAS float* s = scr + (16 * c) * 65 + n;
        u32x4 o;
#pragma unroll
        for (int q = 0; q < 4; ++q) { int w = __builtin_amdgcn_cvt_pk_fp8_f32(pg8::sat8(s[(4 * q) * 65]), pg8::sat8(s[(4 * q + 1) * 65]), 0, false);
            w = __builtin_amdgcn_cvt_pk_fp8_f32(pg8::sat8(s[(4 * q + 2) * 65]), pg8::sat8(s[(4 * q + 3) * 65]), w, true); o[q] = (unsigned)w; }
        *(u32x4*)(d1 + (size_t)n * K + 16 * c) = o; }
    asm volatile("s_waitcnt lgkmcnt(0)" ::: "memory");
}
struct Ptrs {
    const float* x; const float* ret_w_in; const float* ret_w_out; const float* sb_w_kv; const float* sb_w_q; const float* sb_w_out;
    const float* ln_mix_g; const float* ln_mix_b; const float* ln_ffn_g; const float* ln_ffn_b; const float* ffn_w_in; const float* ffn_w_out;
    const float* moe_w_router; const float* moe_w_in; const float* moe_w_out;
    float* out; unsigned char* ws;
};

__device__ __forceinline__ void phase0(const Ptrs& P, LAS unsigned char* lds, int gw, int NGW, int lane, int gtid, int NT) {
    unsigned char* ws = P.ws;
    LAS float* scr = (LAS float*)(lds + (threadIdx.x >> 6) * 16640);
    constexpr int I0 = 16 * 96, I1 = 32 * 16, I2 = 16 * 32, I3 = 16 * 16, I4 = 16 * 16, I5 = 16 * 88, I6 = 44 * 16, I7 = 8 * 16 * 112, I8 = 8 * 56 * 16;
    constexpr int NITEMS = I0 + I1 + I2 + I3 + I4 + I5 + I6 + I7 + I8;
    for (int it = gw; it < NITEMS; it += NGW) {
        int r = it;
        if (r < I0) { const int kb = r / 96, nb = r % 96, k0 = kb * 64, n0 = nb * 64; const float* src = P.ret_w_in + (size_t)k0 * 6144 + n0;
            bf16 *d1, *d2 = nullptr; float sc = 1.f;
            if (n0 < 1024) d1 = (bf16*)(ws + WS_W1A) + (size_t)n0 * 1024 + k0;
            else if (n0 < 2048) { d1 = (bf16*)(ws + WS_W1A) + (size_t)n0 * 1024 + k0; sc = 0.0625f; }
            else if (n0 < 4096) d1 = (bf16*)(ws + WS_W1B) + (size_t)(n0 - 2048) * 1024 + k0;
            else d1 = (bf16*)(ws + WS_W1A) + (size_t)(n0 - 2048) * 1024 + k0;
            tr_tile(src, 6144, 1024, d1, d2, sc, scr, lane); continue; } r -= I0;
        if (r < I1) { const int kb = r / 16, nb = r % 16, k0 = kb * 64, n0 = nb * 64;
            tr_tile(P.ret_w_out + (size_t)k0 * 1024 + n0, 1024, 2048, (bf16*)(ws + WS_W4) + (size_t)n0 * 2048 + k0, nullptr, 1.f, scr, lane); continue; } r -= I1;
        if (r < I2) { const int kb = r / 32, nb = r % 32, k0 = kb * 64, n0 = nb * 64;
            bf16* d1 = n0 < 1024 ? (bf16*)(ws + WS_W9A) + (size_t)n0 * 1024 + k0 : (bf16*)(ws + WS_W9B) + (size_t)(n0 - 1024) * 1024 + k0;
            tr_tile(P.sb_w_kv + (size_t)k0 * 2048 + n0, 2048, 1024, d1, nullptr, 1.f, scr, lane); continue; } r -= I2;
        if (r < I3) { const int kb = r / 16, nb = r % 16, k0 = kb * 64, n0 = nb * 64;
            tr_tile(P.sb_w_q + (size_t)k0 * 1024 + n0, 1024, 1024, (bf16*)(ws + WS_W9A) + (size_t)(1024 + n0) * 1024 + k0, nullptr, 0.125f * 1.4426950408889634f, scr, lane); continue; } r -= I3;
        if (r < I4) { const int kb = r / 16, nb = r % 16, k0 = kb * 64, n0 = nb * 64;
            tr_tile(P.sb_w_out + (size_t)k0 * 1024 + n0, 1024, 1024, (bf16*)(ws + WS_W11) + (size_t)n0 * 1024 + k0, nullptr, 1.f, scr, lane); continue; } r -= I4;
        if (r < I5) { const int kb = r / 88, nb = r % 88, k0 = kb * 64, n0 = nb * 64;
            tr_tile_f8(P.ffn_w_in + (size_t)k0 * 5632 + n0, 5632, 1024, (unsigned char*)(ws + WS_W6) + (size_t)swi_row(n0, DFF) * 1024 + k0, W6_SCALE, scr, lane); continue; } r -= I5;
        if (r < I6) { const int kb = r / 16, nb = r % 16, k0 = kb * 64, n0 = nb * 64;
            tr_tile_f8(P.ffn_w_out + (size_t)k0 * 1024 + n0, 1024, DFF, (unsigned char*)(ws + WS_W7) + (size_t)n0 * DFF + k0, W7_SCALE, scr, lane); continue; } r -= I6;
        if (r < I7) { const int e = r / (16 * 112), q = r % (16 * 112), kb = q / 112, nb = q % 112, k0 = kb * 64, n0 = nb * 64;
            tr_tile_f8(P.moe_w_in + (size_t)e * 1024 * 7168 + (size_t)k0 * 7168 + n0, 7168, 1024, (unsigned char*)(ws + WS_W13) + ((size_t)e * 7168 + swi_row(n0, DEXP)) * 1024 + k0, W13_SCALE, scr, lane); continue; } r -= I7;
        { const int e = r / (56 * 16), q = r % (56 * 16), kb = q / 16, nb = q % 16, k0 = kb * 64, n0 = nb * 64;
            tr_tile_f8(P.moe_w_out + (size_t)e * DEXP * 1024 + (size_t)k0 * 1024 + n0, 1024, DEXP, (unsigned char*)(ws + WS_W14) + ((size_t)e * 1024 + n0) * DEXP + k0, W14_SCALE, scr, lane); }
    }
    { const f32x4* xs = (const f32x4*)P.x; u32x4* xd = (u32x4*)(ws + WS_XB);
      for (int i = gtid; i < NTOK * DM / 8; i += NT) { const f32x4 a = xs[2 * i], b = xs[2 * i + 1];
          u32x4 o; o.x = cvt_pk_bf16(a[0], a[1]); o.y = cvt_pk_bf16(a[2], a[3]); o.z = cvt_pk_bf16(b[0], b[1]); o.w = cvt_pk_bf16(b[2], b[3]); xd[i] = o; } }
    { float* cosN = (float*)(ws + WS_ROPE); float* sinN = cosN + 4096 * 128; float* cosT = sinN + 4096 * 128; float* sinT = cosT + 4096 * 128;
      for (int i = gtid; i < 4096 * 128; i += NT) { const int pos = i >> 7, f = i & 127;
          const float inv = (float)(1.0 / pow(10000.0, (double)(2 * f) / 256.0));
          const float ang = (float)pos * inv;
          float s, c; sincosf(ang, &s, &c);
          cosN[i] = c; sinN[i] = s; } }
    if (blockIdx.x == 0) {
        int* ctl = (int*)(ws + WS_CTL);
        if (threadIdx.x < 32) ctl[threadIdx.x] = 0;
        if (threadIdx.x < 256) { const int h = threadIdx.x >> 6, m = threadIdx.x & 63;
            const float lg = logf(1.0f - exp2f(-5.0f - (float)h));
            ((float*)(ws + WS_CTL))[1024 + threadIdx.x] = expf(lg * (float)(63 - m)); }
    }
}


__device__ __forceinline__ void ret_scores_phase(LAS unsigned char* lds, const bf16* QK, bf16* PB, int vcu, int G) {
    int tid_ = threadIdx.x; asm volatile("" : "+v"(tid_));
    const int tid = tid_, lane = tid & 63, w = __builtin_amdgcn_readfirstlane(tid >> 6), fr = lane & 15, fq = lane >> 4;
    const int nb = w & 3, mbase = (w >> 2) * 2;
    constexpr int QS = 0, KS = 33792;
    u32x4 rq[4], rk[4];
#define SC_LOAD(uu) do { const int bh_ = (uu) >> 6, ch_ = (uu) & 63; const bf16* g_ = QK + ((size_t)(bh_ >> 2) * SEQ + ch_ * 64 + (tid >> 5)) * 2048 + (bh_ & 3) * 256 + (tid & 31) * 8; \
        _Pragma("unroll") for (int k = 0; k < 4; ++k) { rq[k] = *(const u32x4*)(g_ + (size_t)(16 * k) * 2048); rk[k] = *(const u32x4*)(g_ + (size_t)(16 * k) * 2048 + 1024); } } while (0)
    if (vcu < 1024) SC_LOAD(vcu);
    for (int u = vcu; u < 1024; u += G) {
        const int bh = u >> 6, h = bh & 3;
        const float lg2 = log2f(1.0f - exp2f(-5.0f - (float)h));
        __syncthreads();
#pragma unroll
        for (int k = 0; k < 4; ++k) {
            *(LAS u32x4*)(lds + QS + ((tid >> 5) + 16 * k) * 528 + (tid & 31) * 16) = rq[k];
            *(LAS u32x4*)(lds + KS + ((tid >> 5) + 16 * k) * 528 + (tid & 31) * 16) = rk[k]; }
        if (u + G < 1024) SC_LOAD(u + G);
        __syncthreads();
        f32x4 p0 = (f32x4){0.f, 0.f, 0.f, 0.f}, p1 = p0;
#pragma unroll
        for (int kk = 0; kk < 8; ++kk) {
            const bf16x8 qf = *(const LAS bf16x8*)(lds + QS + (nb * 16 + fr) * 528 + kk * 64 + fq * 16);
            const bf16x8 k0f = *(const LAS bf16x8*)(lds + KS + (mbase * 16 + fr) * 528 + kk * 64 + fq * 16);
            const bf16x8 k1f = *(const LAS bf16x8*)(lds + KS + ((mbase + 1) * 16 + fr) * 528 + kk * 64 + fq * 16);
            p0 = __builtin_amdgcn_mfma_f32_16x16x32_bf16(k0f, qf, p0, 0, 0, 0);
            p1 = __builtin_amdgcn_mfma_f32_16x16x32_bf16(k1f, qf, p1, 0, 0, 0);
        }
        const int n = nb * 16 + fr;
        bf16* dst = PB + ((size_t)u * 64 + n) * 64;
#pragma unroll
        for (int t = 0; t < 2; ++t) { const f32x4 p = t ? p1 : p0; const int m0 = (mbase + t) * 16 + 4 * fq; float d[4];
#pragma unroll
            for (int j = 0; j < 4; ++j) d[j] = exp2f(lg2 * (fabsf((float)(n - (m0 + j))) - (float)(63 - (m0 + j))));
            u32x2 pk; pk.x = cvt_pk_bf16(p[0] * d[0], p[1] * d[1]); pk.y = cvt_pk_bf16(p[2] * d[2], p[3] * d[3]);
            *(u32x2*)(dst + m0) = pk; }
    }
#undef SC_LOAD
    __syncthreads();
}
__device__ __forceinline__ void retention_phase(LAS unsigned char* lds, const bf16* QK, const bf16* KVT, const bf16* PB, bf16* O, int vcu, int G) {
    int tid_ = threadIdx.x; asm volatile("" : "+v"(tid_));
    const int tid = tid_, lane = tid & 63, w = __builtin_amdgcn_readfirstlane(tid >> 6), fr = lane & 15, fq = lane >> 4;
    constexpr int QS = 0, KTS = 33792, VTS = 70656, PS = 75264, STS = 84480;
    const bf16* VT = KVT;
    const int nb = w & 3, eb = w >> 2;
    const int trq = (lane & 15) >> 2, trp = lane & 3;
    for (int item = vcu; item < 256; item += G) {
        const int bh = item >> 4, es = item & 15, b = bh >> 2, h = bh & 3;
        const float lg2 = log2f(1.0f - exp2f(-5.0f - (float)h));
        const float qd = exp2f(lg2 * (float)(nb * 16 + fr + 1)), cd = exp2f(lg2 * 64.0f);
        f32x4 accS[2][2];
#pragma unroll
        for (int a = 0; a < 2; ++a)
#pragma unroll
            for (int c = 0; c < 2; ++c) accS[a][c] = (f32x4){0.f, 0.f, 0.f, 0.f};
        __syncthreads();
        for (int i = tid; i < 16896 / 4; i += 512) ((LAS unsigned*)(lds + STS))[i] = 0u;
        const size_t tokb = (size_t)b * SEQ;
        const bf16* gq = QK + (tokb + (tid >> 5)) * 2048 + h * 256 + (tid & 31) * 8;
        const bf16* gvt = VT + (size_t)(h * 512 + es * 32 + ((tid & 255) >> 3)) * 16384 + tokb + (tid & 7) * 8;
        const bf16* gp = PB + (size_t)bh * 64 * 4096 + tid * 8;
        u32x4 rq[4], rkt[4], rvt, rp;
#define RET_LOAD(ch) do { _Pragma("unroll") for (int k = 0; k < 4; ++k) { \
            rq[k] = *(const u32x4*)(gq + (size_t)((ch) * 64 + 16 * k) * 2048); \
            rkt[k] = *(const u32x4*)(gq + (size_t)((ch) * 64 + 16 * k) * 2048 + 1024); } \
            rvt = *(const u32x4*)(gvt + (ch) * 64); rp = *(const u32x4*)(gp + (size_t)(ch) * 4096); } while (0)
        RET_LOAD(0);
        for (int ch = 0; ch < 64; ++ch) {
#pragma unroll
            for (int k = 0; k < 4; ++k) {
                *(LAS u32x4*)(lds + QS + ((tid >> 5) + 16 * k) * 528 + (tid & 31) * 16) = rq[k];
                *(LAS u32x4*)(lds + KTS + ((tid >> 5) + 16 * k) * 544 + (tid & 31) * 16) = rkt[k]; }
            if (tid < 256) *(LAS u32x4*)(lds + VTS + (tid >> 3) * 144 + (tid & 7) * 16) = rvt;
            *(LAS u32x4*)(lds + PS + (tid >> 3) * 144 + (tid & 7) * 16) = rp;
            if (ch + 1 < 64) RET_LOAD(ch + 1);
            __syncthreads();
            f32x4 ao = (f32x4){0.f, 0.f, 0.f, 0.f};
#pragma unroll
            for (int kk = 0; kk < 8; ++kk) {
                const bf16x8 qf = *(const LAS bf16x8*)(lds + QS + (nb * 16 + fr) * 528 + kk * 64 + fq * 16);
                const bf16x8 sf = *(const LAS bf16x8*)(lds + STS + (eb * 16 + fr) * 528 + kk * 64 + fq * 16);
                ao = __builtin_amdgcn_mfma_f32_16x16x32_bf16(sf, qf, ao, 0, 0, 0);
            }
            ao = ao * qd;
#pragma unroll
            for (int kk = 0; kk < 2; ++kk) {
                const bf16x8 vf = *(const LAS bf16x8*)(lds + VTS + (eb * 16 + fr) * 144 + kk * 64 + fq * 16);
                const bf16x8 pf = *(const LAS bf16x8*)(lds + PS + (nb * 16 + fr) * 144 + kk * 64 + fq * 16);
                ao = __builtin_amdgcn_mfma_f32_16x16x32_bf16(vf, pf, ao, 0, 0, 0);
            }
            { u32x2 pk; pk.x = cvt_pk_bf16(ao[0], ao[1]); pk.y = cvt_pk_bf16(ao[2], ao[3]);
              *(u32x2*)(O + (tokb + ch * 64 + nb * 16 + fr) * 2048 + h * 512 + es * 32 + eb * 16 + 4 * fq) = pk; }
#pragma unroll
            for (int a = 0; a < 2; ++a)
#pragma unroll
                for (int c = 0; c < 2; ++c) accS[a][c] = accS[a][c] * cd;
#pragma unroll
            for (int kk = 0; kk < 2; ++kk) {
                const bf16x8 v0f = *(const LAS bf16x8*)(lds + VTS + fr * 144 + kk * 64 + fq * 16);
                const bf16x8 v1f = *(const LAS bf16x8*)(lds + VTS + (16 + fr) * 144 + kk * 64 + fq * 16);
#pragma unroll
                for (int di = 0; di < 2; ++di) {
                    const LAS unsigned char* kp = lds + KTS + (32 * kk + 8 * fq + trq) * 544 + 32 * (2 * w + di) + 8 * trp;
                    const s16x4_t klo = __builtin_bit_cast(s16x4_t, __builtin_amdgcn_ds_read_tr16_b64_v4i16((LAS s16x4_t*)kp));
                    const s16x4_t khi = __builtin_bit_cast(s16x4_t, __builtin_amdgcn_ds_read_tr16_b64_v4i16((LAS s16x4_t*)(kp + 4 * 544)));
                    const bf16x8 kf = __builtin_shufflevector(klo, khi, 0, 1, 2, 3, 4, 5, 6, 7);
                    accS[di][0] = __builtin_amdgcn_mfma_f32_16x16x32_bf16(kf, v0f, accS[di][0], 0, 0, 0);
                    accS[di][1] = __builtin_amdgcn_mfma_f32_16x16x32_bf16(kf, v1f, accS[di][1], 0, 0, 0);
                }
            }
            __syncthreads();
#pragma unroll
            for (int di = 0; di < 2; ++di)
#pragma unroll
                for (int c = 0; c < 2; ++c) { u32x2 pk; pk.x = cvt_pk_bf16(accS[di][c][0], accS[di][c][1]); pk.y = cvt_pk_bf16(accS[di][c][2], accS[di][c][3]);
                    *(LAS u32x2*)(lds + STS + (c * 16 + fr) * 528 + ((2 * w + di) * 16 + 4 * fq) * 2) = pk; }
        }
#undef RET_LOAD
    }
}

__device__ __forceinline__ void gn_gate_phase(const bf16* O, const bf16* Gt, bf16* A, int gw, int NGW, int lane) {
    for (int tok = gw; tok < NTOK; tok += NGW) {
#pragma unroll
        for (int hh = 0; hh < 4; ++hh) {
            const size_t off = (size_t)tok * 2048 + hh * 512 + lane * 8;
            const u32x4 ov = *(const u32x4*)(O + off), gv = *(const u32x4*)(Gt + off);
            float o[8], g[8]; unpack8(ov, o); unpack8(gv, g);
            float s = 0.f;
#pragma unroll
            for (int j = 0; j < 8; ++j) s += o[j];
            const float mean = wave_sum(s) * (1.0f / 512.0f); float q = 0.f;
#pragma unroll
            for (int j = 0; j < 8; ++j) { o[j] -= mean; q += o[j] * o[j]; }
            const float rstd = 1.0f / sqrtf(wave_sum(q) * (1.0f / 512.0f) + LN_EPS);
            float r[8];
#pragma unroll
            for (int j = 0; j < 8; ++j) { const float sg = g[j] / (1.0f + __expf(-g[j])); r[j] = sg * o[j] * rstd; }
            u32x4 w; w.x = cvt_pk_bf16(r[0], r[1]); w.y = cvt_pk_bf16(r[2], r[3]); w.z = cvt_pk_bf16(r[4], r[5]); w.w = cvt_pk_bf16(r[6], r[7]);
            *(u32x4*)(A + off) = w;
        }
    }
}

__device__ __forceinline__ void ln_row(const float* rrow, const bf16* mrow, const float* gam, const float* bet, float* xfrow, bf16* xbrow, int lane, f32x4 (&v)[4]) {
    const f32x4* rr = (const f32x4*)rrow + lane; const u32x2* mr = (const u32x2*)mrow + lane; float s = 0.f;
#pragma unroll
    for (int j = 0; j < 4; ++j) { const u32x2 a = mr[64 * j];
        const f32x4 mv = (f32x4){__uint_as_float(a.x << 16), __uint_as_float(a.x & 0xffff0000u), __uint_as_float(a.y << 16), __uint_as_float(a.y & 0xffff0000u)};
        v[j] = rr[64 * j] * ALPHA + mv; s += (v[j][0] + v[j][1]) + (v[j][2] + v[j][3]); }
    const float mean = wave_sum(s) * (1.0f / DM); float q = 0.f;
#pragma unroll
    for (int j = 0; j < 4; ++j) { v[j] = v[j] - mean; q += (v[j][0] * v[j][0] + v[j][1] * v[j][1]) + (v[j][2] * v[j][2] + v[j][3] * v[j][3]); }
    const float rstd = 1.0f / sqrtf(wave_sum(q) * (1.0f / DM) + LN_EPS);
#pragma unroll
    for (int j = 0; j < 4; ++j) { const f32x4 gg = ((const f32x4*)gam)[lane + 64 * j], bb = ((const f32x4*)bet)[lane + 64 * j]; v[j] = v[j] * rstd * gg + bb;
        ((f32x4*)xfrow)[lane + 64 * j] = v[j];
        if (xbrow) { u32x2 w; w.x = cvt_pk_bf16(v[j][0], v[j][1]); w.y = cvt_pk_bf16(v[j][2], v[j][3]); ((u32x2*)xbrow)[lane + 64 * j] = w; } }
}
__device__ __forceinline__ void ln_phase_f8(const float* RES, const bf16* MIX, const float* gam, const float* bet, float* XF, unsigned char* X8, int gw, int NGW, int lane) {
    for (int m = gw; m < NTOK; m += NGW) { f32x4 v[4]; ln_row(RES + (size_t)m * DM, MIX + (size_t)m * DM, gam, bet, XF + (size_t)m * DM, nullptr, lane, v);
#pragma unroll
        for (int j = 0; j < 4; ++j) { int w = __builtin_amdgcn_cvt_pk_fp8_f32(pg8::sat8(v[j][0]), pg8::sat8(v[j][1]), 0, false); w = __builtin_amdgcn_cvt_pk_fp8_f32(pg8::sat8(v[j][2]), pg8::sat8(v[j][3]), w, true);
            ((unsigned*)(X8 + (size_t)m * DM))[lane + 64 * j] = (unsigned)w; } }
}
__device__ __forceinline__ void ln_phase(const float* RES, const bf16* MIX, const float* gam, const float* bet, float* XF, bf16* XB, int gw, int NGW, int lane) {
    for (int m = gw; m < NTOK; m += NGW) { f32x4 v[4]; ln_row(RES + (size_t)m * DM, MIX + (size_t)m * DM, gam, bet, XF + (size_t)m * DM, XB ? XB + (size_t)m * DM : nullptr, lane, v); }
}
__device__ __forceinline__ void ln_router_phase(LAS unsigned char* lds, const float* RES, const bf16* MIX, const float* gam, const float* bet, float* XF, bf16* XB, const float* wrt, unsigned char* ws, int gw, int NGW, int lane) {
    LAS float* wl = (LAS float*)lds;
    LAS int* lcnt = (LAS int*)(lds + 32768);
    LAS int* rl = (LAS int*)(lds + 32768 + 64);
    const int wave = threadIdx.x >> 6;
    __syncthreads();
    for (int i = threadIdx.x; i < 1024 * 8 / 4; i += 512) ((LAS f32x4*)wl)[i] = ((const f32x4*)wrt)[i];
    if (threadIdx.x < 16) lcnt[threadIdx.x] = 0;
    __syncthreads();
    int* cnt = (int*)(ws + WS_CTL);
    int* route = (int*)(ws + WS_ROUTE); float* wts = (float*)(ws + WS_ROUTE + 512 * 1024);
    int k = 0;
    for (int m = gw; m < NTOK; m += NGW, ++k) {
        f32x4 v[4]; ln_row(RES + (size_t)m * DM, MIX + (size_t)m * DM, gam, bet, XF + (size_t)m * DM, nullptr, lane, v);
#pragma unroll
        for (int j = 0; j < 4; ++j) { int w8 = __builtin_amdgcn_cvt_pk_fp8_f32(pg8::sat8(v[j][0]), pg8::sat8(v[j][1]), 0, false); w8 = __builtin_amdgcn_cvt_pk_fp8_f32(pg8::sat8(v[j][2]), pg8::sat8(v[j][3]), w8, true);
            ((unsigned*)((unsigned char*)XB + (size_t)m * DM))[lane + 64 * j] = (unsigned)w8; }
        float lg[8];
#pragma unroll
        for (int e = 0; e < 8; ++e) lg[e] = 0.f;
#pragma unroll
        for (int j = 0; j < 4; ++j)
#pragma unroll
            for (int c = 0; c < 4; ++c) { const int i = 256 * j + 4 * lane + c; const f32x4 w0 = ((const LAS f32x4*)wl)[2 * i], w1 = ((const LAS f32x4*)wl)[2 * i + 1]; const float xv = v[j][c];
                lg[0] += xv * w0[0]; lg[1] += xv * w0[1]; lg[2] += xv * w0[2]; lg[3] += xv * w0[3]; lg[4] += xv * w1[0]; lg[5] += xv * w1[1]; lg[6] += xv * w1[2]; lg[7] += xv * w1[3]; }
#pragma unroll
        for (int e = 0; e < 8; ++e) lg[e] = wave_sum(lg[e]);
        float v1 = lg[0]; int i1 = 0;
#pragma unroll
        for (int e = 1; e < 8; ++e) if (lg[e] > v1) { v1 = lg[e]; i1 = e; }
        float v2 = -3.0e38f; int i2 = 0;
#pragma unroll
        for (int e = 0; e < 8; ++e) if (e != i1 && lg[e] > v2) { v2 = lg[e]; i2 = e; }
        if (lane == 0) {
            const float ex = expf(v2 - v1), w1 = 1.0f / (1.0f + ex), w2 = ex / (1.0f + ex);
            const int p1 = __hip_atomic_fetch_add(lcnt + i1, 1, __ATOMIC_RELAXED, __HIP_MEMORY_SCOPE_WORKGROUP), p2 = __hip_atomic_fetch_add(lcnt + i2, 1, __ATOMIC_RELAXED, __HIP_MEMORY_SCOPE_WORKGROUP);
            LAS int* r = rl + (wave * 16 + (k & 15)) * 4; r[0] = i1; r[1] = p1; r[2] = i2; r[3] = p2;
            wts[2 * m] = w1; wts[2 * m + 1] = w2;
        }
    }
    __syncthreads();
    if (threadIdx.x < 8) lcnt[8 + threadIdx.x] = atomicAdd(cnt + threadIdx.x, lcnt[threadIdx.x]);
    __syncthreads();
    { const int t = threadIdx.x; const int wv = t >> 4, kk = t & 15;
      if (wv < 8) { const int m = (gw - wave + wv) + kk * NGW;
        if (kk < 16 && m < NTOK && t < 128) { const LAS int* r = rl + (wv * 16 + kk) * 4; const int e1 = r[0], e2 = r[2];
            route[4 * m] = e1; route[4 * m + 1] = lcnt[8 + e1] + r[1]; route[4 * m + 2] = e2; route[4 * m + 3] = lcnt[8 + e2] + r[3]; } } }
}
__device__ __forceinline__ void gather_phase(LAS unsigned char* lds, const bf16* XB, unsigned char* XP, unsigned char* ws, int gw, int NGW, int lane) {
    LAS int* offl = (LAS int*)lds;
    int* ctl = (int*)(ws + WS_CTL);
    __syncthreads();
    if (threadIdx.x == 0) { int off = 0;
        for (int e = 0; e < 8; ++e) { const int c = __hip_atomic_load(ctl + e, __ATOMIC_RELAXED, __HIP_MEMORY_SCOPE_AGENT); offl[e] = off;
            const int nt = (c + 255) >> 8;
            if (blockIdx.x == 0) for (int t = 0; t < nt; ++t) ctl[32 + (off >> 8) + t] = e;
            off += nt * 256; }
        offl[8] = off; if (blockIdx.x == 0) ctl[16] = off >> 8; }
    __syncthreads();
    const int* route = (const int*)(ws + WS_ROUTE); int* rows = (int*)(ws + WS_ROUTE + 768 * 1024);
    for (int m = gw; m < NTOK; m += NGW) {
        const int e1 = route[4 * m], p1 = route[4 * m + 1], e2 = route[4 * m + 2], p2 = route[4 * m + 3];
        const int r1 = offl[e1] + p1, r2 = offl[e2] + p2;
        const u32x4 o = ((const u32x4*)((const unsigned char*)XB + (size_t)m * DM))[lane];
        ((u32x4*)(XP + (size_t)r1 * DM))[lane] = o; ((u32x4*)(XP + (size_t)r2 * DM))[lane] = o;
        if (lane == 0) { rows[2 * m] = r1; rows[2 * m + 1] = r2; }
    }
}
__device__ __forceinline__ void final_phase(const float* XF, const bf16* YP, const float* gam, const float* bet, float* out, unsigned char* ws, int gw, int NGW, int lane) {
    const int* rows = (const int*)(ws + WS_ROUTE + 768 * 1024); const float* wts = (const float*)(ws + WS_ROUTE + 512 * 1024);
    for (int m = gw; m < NTOK; m += NGW) {
        const int r1 = rows[2 * m], r2 = rows[2 * m + 1]; const float w1 = wts[2 * m], w2 = wts[2 * m + 1];
        const f32x4* xr = (const f32x4*)(XF + (size_t)m * DM) + lane; const u32x2* y1 = (const u32x2*)(YP + (size_t)r1 * DM) + lane; const u32x2* y2 = (const u32x2*)(YP + (size_t)r2 * DM) + lane;
        f32x4 v[4]; float s = 0.f;
#pragma unroll
        for (int j = 0; j < 4; ++j) { const u32x2 a = y1[64 * j], b = y2[64 * j];
            const f32x4 ya = (f32x4){__uint_as_float(a.x << 16), __uint_as_float(a.x & 0xffff0000u), __uint_as_float(a.y << 16), __uint_as_float(a.y & 0xffff0000u)};
            const f32x4 yb = (f32x4){__uint_as_float(b.x << 16), __uint_as_float(b.x & 0xffff0000u), __uint_as_float(b.y << 16), __uint_as_float(b.y & 0xffff0000u)};
            v[j] = xr[64 * j] * ALPHA + (ya * w1 + yb * w2); s += (v[j][0] + v[j][1]) + (v[j][2] + v[j][3]); }
        const float mean = wave_sum(s) * (1.0f / DM); float q = 0.f;
#pragma unroll
        for (int j = 0; j < 4; ++j) { v[j] = v[j] - mean; q += (v[j][0] * v[j][0] + v[j][1] * v[j][1]) + (v[j][2] * v[j][2] + v[j][3] * v[j][3]); }
        const float rstd = 1.0f / sqrtf(wave_sum(q) * (1.0f / DM) + LN_EPS);
#pragma unroll
        for (int j = 0; j < 4; ++j) { const f32x4 gg = ((const f32x4*)gam)[lane + 64 * j], bb = ((const f32x4*)bet)[lane + 64 * j];
            ((f32x4*)(out + (size_t)m * DM))[lane + 64 * j] = v[j] * rstd * gg + bb; }
    }
}

#ifndef SB_CUT
#define SB_CUT (-150.1f)
#endif
__device__ __forceinline__ void sb_attn_phase(LAS unsigned char* lds, const bf16* KQ, const bf16* VT2, bf16* O, int vcu, int G) {
    int tid_ = threadIdx.x; asm volatile("" : "+v"(tid_));
    const int tid = tid_, lane = tid & 63, w = __builtin_amdgcn_readfirstlane(tid >> 6), fr = lane & 15, fq = lane >> 4;
    constexpr int VB = 18432, FLG = 36864;
    volatile LAS int* flags = (volatile LAS int*)(lds + FLG);
    bf16x8 tri[4][2];
#pragma unroll
    for (int a = 0; a < 4; ++a)
#pragma unroll
        for (int ks = 0; ks < 2; ++ks)
#pragma unroll
            for (int j = 0; j < 8; ++j) { const int sk = 16 * (2 * ks + (j >> 2)) + 4 * fq + (j & 3), sp = 16 * a + fr; tri[a][ks][j] = (sk >= sp) ? (short)0x3F80 : (short)0; }
    for (int L = vcu; L < 1024; L += G) {
        const int bh = L >> 4; int qb = L & 15; if ((L >> 8) & 1) qb = 15 - qb;
        const int b = bh >> 4, h = bh & 15;
        const int q0 = qb * 256, tw = q0 + 32 * w;
        const size_t tokb = (size_t)b * SEQ;
        bf16x8 qf[2][2];
#pragma unroll
        for (int qi = 0; qi < 2; ++qi)
#pragma unroll
            for (int kk = 0; kk < 2; ++kk) qf[qi][kk] = *(const bf16x8*)(KQ + (tokb + tw + 16 * qi + fr) * 2048 + 1024 + h * 64 + kk * 32 + 8 * fq);
        f32x4 oacc[2][4];
#pragma unroll
        for (int qi = 0; qi < 2; ++qi)
#pragma unroll
            for (int d = 0; d < 4; ++d) oacc[qi][d] = (f32x4){0.f, 0.f, 0.f, 0.f};
        float R0 = 0.f, R1 = 0.f; int done = 0;
        const int ntile = (q0 + 256) >> 6;
        const bf16* gk = KQ + (tokb + (tid >> 3)) * 2048 + h * 64 + (tid & 7) * 8;
        const bf16* gv = VT2 + (size_t)(h * 64 + (tid >> 3)) * 16384 + tokb + (tid & 7) * 8;
        const int lwo = (tid >> 3) * 144 + (tid & 7) * 16;
        __syncthreads();
        if (tid < 16) flags[tid] = 0;
        u32x4 rk = *(const u32x4*)(gk + (size_t)((ntile - 1) * 64) * 2048), rv = *(const u32x4*)(gv + (ntile - 1) * 64);
        *(LAS u32x4*)(lds + lwo) = rk; *(LAS u32x4*)(lds + VB + lwo) = rv;
        int cur = 0;
        for (int it = 0; it < ntile; ++it) {
            const int j0 = (ntile - 1 - it) * 64;
            __syncthreads();
            { int all = 1;
#pragma unroll
              for (int i = 0; i < 8; ++i) all &= flags[(it & 1) * 8 + i];
              if (all) break; }
            if (it + 1 < ntile) { rk = *(const u32x4*)(gk + (size_t)(j0 - 64) * 2048); rv = *(const u32x4*)(gv + (j0 - 64)); }
            if (!done && j0 < tw + 32) {
                const bool need_mask = (j0 + 63 >= tw);
                const LAS unsigned char* kb = lds + cur * 9216; const LAS unsigned char* vb = lds + VB + cur * 9216;
                bf16x8 kf[4][2];
#pragma unroll
                for (int a = 0; a < 4; ++a)
#pragma unroll
                    for (int kk = 0; kk < 2; ++kk) kf[a][kk] = *(const LAS bf16x8*)(kb + (16 * a + fr) * 144 + kk * 64 + fq * 16);
                bf16x8 pf[2][2]; bool act0 = false, act1 = false;
#pragma unroll
                for (int qi = 0; qi < 2; ++qi) {
                    const int t = tw + 16 * qi + fr;
                    const bool act = (j0 < tw + 16 * qi + 16) && !__all((qi ? R1 : R0) < SB_CUT);
                    if (qi) act1 = act; else act0 = act;
                    if (!act) continue;
                    f32x4 z[4], lk[4];
#pragma unroll
                    for (int a = 0; a < 4; ++a) { z[a] = __builtin_amdgcn_mfma_f32_16x16x32_bf16(kf[a][0], qf[qi][0], (f32x4){0.f, 0.f, 0.f, 0.f}, 0, 0, 0);
                        z[a] = __builtin_amdgcn_mfma_f32_16x16x32_bf16(kf[a][1], qf[qi][1], z[a], 0, 0, 0); }
#pragma unroll
                    for (int a = 0; a < 4; ++a)
#pragma unroll
                        for (int j = 0; j < 4; ++j) { const float zz = z[a][j]; const float e = __builtin_amdgcn_exp2f(-fabsf(zz)); float v = -(fmaxf(zz, 0.f) + __builtin_amdgcn_logf(1.0f + e));
                            if (need_mask) { const int s = j0 + 16 * a + 4 * fq + j; if (s >= t) v = 0.f; }
                            lk[a][j] = v; }
                    bf16x8 lf[2];
#pragma unroll
                    for (int ks = 0; ks < 2; ++ks) { u32x4 pk; pk.x = cvt_pk_bf16(lk[2 * ks][0], lk[2 * ks][1]); pk.y = cvt_pk_bf16(lk[2 * ks][2], lk[2 * ks][3]);
                        pk.z = cvt_pk_bf16(lk[2 * ks + 1][0], lk[2 * ks + 1][1]); pk.w = cvt_pk_bf16(lk[2 * ks + 1][2], lk[2 * ks + 1][3]); lf[ks] = __builtin_bit_cast(bf16x8, pk); }
                    const float Rv = qi ? R1 : R0;
                    f32x4 c[4];
#pragma unroll
                    for (int a = 0; a < 4; ++a) { c[a] = (f32x4){Rv, Rv, Rv, Rv};
                        if (a < 2) c[a] = __builtin_amdgcn_mfma_f32_16x16x32_bf16(tri[a][0], lf[0], c[a], 0, 0, 0);
                        c[a] = __builtin_amdgcn_mfma_f32_16x16x32_bf16(tri[a][1], lf[1], c[a], 0, 0, 0); }
                    f32x4 wv[4];
#pragma unroll
                    for (int a = 0; a < 4; ++a)
#pragma unroll
                        for (int j = 0; j < 4; ++j) { float x = __builtin_amdgcn_exp2f(z[a][j] + c[a][j]);
                            if (need_mask) { const int s = j0 + 16 * a + 4 * fq + j; if (s >= t) x = 0.f; }
                            wv[a][j] = x; }
#pragma unroll
                    for (int ks = 0; ks < 2; ++ks) { u32x4 pk; pk.x = cvt_pk_bf16(wv[2 * ks][0], wv[2 * ks][1]); pk.y = cvt_pk_bf16(wv[2 * ks][2], wv[2 * ks][3]);
                        pk.z = cvt_pk_bf16(wv[2 * ks + 1][0], wv[2 * ks + 1][1]); pk.w = cvt_pk_bf16(wv[2 * ks + 1][2], wv[2 * ks + 1][3]); pf[qi][ks] = __builtin_bit_cast(bf16x8, pk); }
                    const float Rn = __shfl(c[0][0], fr);
                    if (qi) R1 = Rn; else R0 = Rn;
                }
#pragma unroll
                for (int d = 0; d < 4; ++d)
#pragma unroll
                    for (int ks = 0; ks < 2; ++ks) {
                        const u32x2 lo = *(const LAS u32x2*)(vb + (16 * d + fr) * 144 + (32 * ks + 4 * fq) * 2);
                        const u32x2 hi = *(const LAS u32x2*)(vb + (16 * d + fr) * 144 + (32 * ks + 16 + 4 * fq) * 2);
                        u32x4 vv; vv.x = lo.x; vv.y = lo.y; vv.z = hi.x; vv.w = hi.y; const bf16x8 vf = __builtin_bit_cast(bf16x8, vv);
                        if (act0) oacc[0][d] = __builtin_amdgcn_mfma_f32_16x16x32_bf16(vf, pf[0][ks], oacc[0][d], 0, 0, 0);
                        if (act1) oacc[1][d] = __builtin_amdgcn_mfma_f32_16x16x32_bf16(vf, pf[1][ks], oacc[1][d], 0, 0, 0);
                    }
                done = __all((R0 < SB_CUT) && (R1 < SB_CUT)) ? 1 : 0;
            }
            if (lane == 0) flags[((it + 1) & 1) * 8 + w] = done;
            if (it + 1 < ntile) { *(LAS u32x4*)(lds + (cur ^ 1) * 9216 + lwo) = rk; *(LAS u32x4*)(lds + VB + (cur ^ 1) * 9216 + lwo) = rv; }
            cur ^= 1;
        }
#pragma unroll
        for (int qi = 0; qi < 2; ++qi)
#pragma unroll
            for (int d = 0; d < 4; ++d) { u32x2 pk; pk.x = cvt_pk_bf16(oacc[qi][d][0], oacc[qi][d][1]); pk.y = cvt_pk_bf16(oacc[qi][d][2], oacc[qi][d][3]);
                *(u32x2*)(O + (tokb + tw + 16 * qi + fr) * DM + h * 64 + 16 * d + 4 * fq) = pk; }
    }
}

__global__ void __launch_bounds__(512, 2) fwd_megakernel(Ptrs P) {
    extern __shared__ __attribute__((aligned(16))) unsigned char lds_raw[];
    LAS unsigned char* lds = (LAS unsigned char*)lds_raw;
    cg::grid_group grid = cg::this_grid();
#define GRID_SYNC() do { asm volatile("s_waitcnt vmcnt(0) lgkmcnt(0)" ::: "memory"); grid.sync(); __builtin_amdgcn_fence(__ATOMIC_ACQUIRE, "agent"); asm volatile("s_waitcnt vmcnt(0)" ::: "memory"); } while (0)
    const int tid = threadIdx.x, lane = tid & 63, wave = __builtin_amdgcn_readfirstlane(tid >> 6);
    const int G = gridDim.x, bx = blockIdx.x;
#ifndef REP_MASK
#define REP_MASK 0
#endif
#define REPS(k) for (int rep_ = 0; rep_ < 1 + ((REP_MASK >> (k)) & 1); ++rep_)
#ifndef DIAG_STOP
#define DIAG_STOP 0
#endif

#define DIAG_BF(k, expr_n, body) do { if (DIAG_STOP == (k)) { float* d_ = P.out; for (int i_ = blockIdx.x * 512 + threadIdx.x; i_ < NTOK * DM; i_ += gridDim.x * 512) { float r_ = 0.f; body; d_[i_] = r_; } return; } } while (0)
#define DIAG_OUT(k) do { if (DIAG_STOP == (k)) { const f32x4* s_ = (const f32x4*)(P.ws + WS_XF); f32x4* d_ = (f32x4*)P.out; for (int i_ = blockIdx.x * 512 + threadIdx.x; i_ < NTOK * DM / 4; i_ += gridDim.x * 512) d_[i_] = s_[i_]; return; } } while (0)
    const int vcu = (G % 8 == 0) ? (bx % 8) * (G / 8) + bx / 8 : bx;
    const int gw = vcu * 8 + wave, NGW = G * 8, gtid = bx * 512 + tid, NT = G * 512;
    unsigned char* ws = P.ws;
    if (tid < 16) ((volatile LAS unsigned*)(lds + 141312))[tid] = 0u;
    __syncthreads();
    bf16* XB = (bf16*)(ws + WS_XB); float* XF = (float*)(ws + WS_XF); bf16* MIX = (bf16*)(ws + WS_Y);
    const float* cosN = (const float*)(ws + WS_ROPE); const float* sinN = cosN + 4096 * 128; const float* cosT = sinN + 4096 * 128; const float* sinT = cosT + 4096 * 128;
    const float* kdt = (const float*)(ws + WS_CTL) + 1024;

    if (ws == nullptr) grid.sync();
    XcdBarrier xbar = xcd_barrier_post((unsigned*)(ws + WS_CTL) + 4096, (volatile LAS unsigned*)(lds + 141312));
    REPS(0) phase0(P, lds, gw, NGW, opq(lane), opq(gtid), NT);
    xcd_barrier(xbar);
    if ((REP_MASK >> 20) & 1) { for (int q_ = 0; q_ < 8; ++q_) xcd_barrier(xbar); }

    { bf16* QK = (bf16*)(ws + WS_RA); bf16* Gt = (bf16*)(ws + WS_RA + 64 * MiB); bf16* KVT = (bf16*)(ws + WS_RA + 128 * MiB);
      REPS(1) { pg8::Gemm g{XB, (const bf16*)(ws + WS_W1A), NTOK, 4096, 1024}; pg8::StaticOrder S; S.init(NTOK, 4096, G, bx);
        pg8::EpiRetNat E{QK, Gt, cosN, sinN, kdt};
        pg8::gemm_phase<pg8::EpiRetNat, pg8::StaticOrder, true, true>(lds, g, S, E); }
      REPS(1) { pg8::Gemm g{(const bf16*)(ws + WS_W1B), XB, 2048, NTOK, 1024}; pg8::StaticOrder S; S.init(2048, NTOK, G, bx, WGM_T);
        pg8::EpiBf16Plain E{KVT, NTOK, 0.f, 0};
        pg8::gemm_phase<pg8::EpiBf16Plain, pg8::StaticOrder, true, true>(lds, g, S, E); }
      xcd_barrier(xbar);
      DIAG_BF(11, 0, { r_ = bf2f(QK[2 * (size_t)i_]) + 1.37f * bf2f(QK[2 * (size_t)i_ + 1]) + 0.61f * bf2f(Gt[2 * (size_t)i_]) + 0.83f * bf2f(Gt[2 * (size_t)i_ + 1]) + 1.11f * bf2f(KVT[3 * (size_t)i_]) + 0.77f * bf2f(KVT[3 * (size_t)i_ + 1]) + 1.51f * bf2f(KVT[3 * (size_t)i_ + 2]); });
      bf16* ORET = (bf16*)(ws + WS_RB); bf16* ARET = (bf16*)(ws + WS_RB + 64 * MiB);
      bf16* PB = (bf16*)(ws + WS_RB + 128 * MiB);
      REPS(5) ret_scores_phase(lds, QK, PB, vcu, G);
      xcd_barrier(xbar);
      REPS(2) retention_phase(lds, QK, KVT, PB, ORET, vcu, G);
      xcd_barrier(xbar);
      DIAG_BF(12, 0, { r_ = bf2f(ORET[2 * (size_t)i_]) + 1.37f * bf2f(ORET[2 * (size_t)i_ + 1]); });
      REPS(3) gn_gate_phase(ORET, Gt, ARET, gw, NGW, opq(lane));
      xcd_barrier(xbar);
      DIAG_BF(13, 0, { r_ = bf2f(ARET[2 * (size_t)i_]) + 1.37f * bf2f(ARET[2 * (size_t)i_ + 1]); });
      REPS(4) { pg8::Gemm g{ARET, (const bf16*)(ws + WS_W4), NTOK, 1024, 2048}; pg8::StaticOrder S; S.init(NTOK, 1024, G, bx);
        pg8::EpiBf16Plain E{MIX, DM, 0.f, 0};
        pg8::gemm_phase<pg8::EpiBf16Plain, pg8::StaticOrder, true, true>(lds, g, S, E); }
      xcd_barrier(xbar); }
    REPS(3) ln_phase_f8(P.x, MIX, P.ln_mix_g, P.ln_mix_b, XF, (unsigned char*)XB, gw, NGW, opq(lane));
    xcd_barrier(xbar);
    DIAG_OUT(1);
    { bf16* H = (bf16*)(ws + WS_RA);
      REPS(6) { pg8::Gemm g{XB, (const bf16*)(ws + WS_W6), NTOK, 2 * DFF, 1024}; pg8::StaticOrder S; S.init(NTOK, 2 * DFF, G, bx);
        pg8::EpiSwiglu E{H, DFF, 0, 1.0f / W6_SCALE, H_SCALE};
        pg8::gemm_phase<pg8::EpiSwiglu, pg8::StaticOrder, true, true, true>(lds, g, S, E); }
      xcd_barrier(xbar);
      REPS(7) { pg8::Gemm g{H, (const bf16*)(ws + WS_W7), NTOK, 1024, DFF}; pg8::StaticOrder S; S.init(NTOK, 1024, G, bx);
        pg8::EpiBf16Plain E{MIX, DM, 1.0f / (W7_SCALE * H_SCALE), 0};
        pg8::gemm_phase<pg8::EpiBf16Plain, pg8::StaticOrder, true, true, true>(lds, g, S, E); }
      xcd_barrier(xbar); }
    REPS(3) ln_phase(XF, MIX, P.ln_ffn_g, P.ln_ffn_b, XF, XB, gw, NGW, opq(lane));
    xcd_barrier(xbar);
    DIAG_OUT(2);
    { bf16* KQ = (bf16*)(ws + WS_RA); bf16* VT2 = (bf16*)(ws + WS_RA + 64 * MiB); bf16* OATT = (bf16*)(ws + WS_RB);
      REPS(9) { pg8::Gemm g{XB, (const bf16*)(ws + WS_W9A), NTOK, 2048, 1024}; pg8::StaticOrder S; S.init(NTOK, 2048, G, bx);
        pg8::EpiBf16Plain E{KQ, 2048, 0.f, 0};
        pg8::gemm_phase<pg8::EpiBf16Plain, pg8::StaticOrder, true, true>(lds, g, S, E); }
      REPS(9) { pg8::Gemm g{(const bf16*)(ws + WS_W9B), XB, 1024, NTOK, 1024}; pg8::StaticOrder S; S.init(1024, NTOK, G, bx, WGM_T);
        pg8::EpiBf16Plain E{VT2, NTOK, 0.f, 0};
        pg8::gemm_phase<pg8::EpiBf16Plain, pg8::StaticOrder, true, true>(lds, g, S, E); }
      xcd_barrier(xbar);
      REPS(10) sb_attn_phase(lds, KQ, VT2, OATT, vcu, G);
      xcd_barrier(xbar);
      REPS(11) { pg8::Gemm g{OATT, (const bf16*)(ws + WS_W11), NTOK, 1024, 1024}; pg8::StaticOrder S; S.init(NTOK, 1024, G, bx);
        pg8::EpiBf16Plain E{MIX, DM, 0.f, 0};
        pg8::gemm_phase<pg8::EpiBf16Plain, pg8::StaticOrder, true, true>(lds, g, S, E); }
      xcd_barrier(xbar); }
    ln_router_phase(lds, XF, MIX, P.ln_mix_g + DM, P.ln_mix_b + DM, XF, XB, P.moe_w_router, ws, gw, NGW, opq(lane));
    xcd_barrier(xbar);
    DIAG_OUT(3);
    { unsigned char* XP = ws + WS_RB; bf16* H2 = (bf16*)(ws + WS_RA); bf16* YP = (bf16*)(ws + WS_RB);
      REPS(3) gather_phase(lds, XB, XP, ws, gw, NGW, opq(lane));
      xcd_barrier(xbar);
      const int* ctl = (const int*)(ws + WS_CTL);
      const int ntiles = __builtin_amdgcn_readfirstlane(__hip_atomic_load(ctl + 16, __ATOMIC_RELAXED, __HIP_MEMORY_SCOPE_AGENT));
      REPS(13) { pg8::Gemm g{(const bf16*)XP, (const bf16*)(ws + WS_W13), ntiles * 256, 28 * 256, 1024}; pg8::MoeOrder S; S.init(ntiles * 256, 28 * 256, G, bx); S.tile_e = ctl + 32; S.NT = 28;
        pg8::EpiSwiglu E{H2, DEXP, 28, 1.0f / W13_SCALE, H2_SCALE};
        pg8::gemm_phase<pg8::EpiSwiglu, pg8::MoeOrder, true, true, true>(lds, g, S, E); }
      xcd_barrier(xbar);
      REPS(14) { pg8::Gemm g{H2, (const bf16*)(ws + WS_W14), ntiles * 256, 4 * 256, DEXP}; pg8::MoeOrder S; S.init(ntiles * 256, 4 * 256, G, bx); S.tile_e = ctl + 32; S.NT = 4;
        pg8::EpiBf16Plain E{YP, DM, 1.0f / (W14_SCALE * H2_SCALE), 4};
        pg8::gemm_phase<pg8::EpiBf16Plain, pg8::MoeOrder, true, true, true>(lds, g, S, E); }
      xcd_barrier(xbar);
      REPS(3) final_phase(XF, YP, P.ln_ffn_g + DM, P.ln_ffn_b + DM, P.out, ws, gw, NGW, opq(lane)); }
}

extern "C" void kernel_launch(void* const* d_in, const int* in_sizes, int n_in, void* d_out, int out_size, void* d_ws, size_t ws_size, hipStream_t stream) {
    static int grid = 0;
    if (grid == 0) {
        if (n_in != 15 || ws_size < WS_END) { fprintf(stderr, "kernel_launch: unexpected n_in %d / ws_size %zu (need %zu)\n", n_in, ws_size, (size_t)WS_END); grid = -1; return; }
        int dev = 0, cus = 0, per_cu = 0;
        hipGetDevice(&dev); hipDeviceGetAttribute(&cus, hipDeviceAttributeMultiprocessorCount, dev);
        if (hipFuncSetAttribute((const void*)fwd_megakernel, hipFuncAttributeMaxDynamicSharedMemorySize, LDS_BYTES) != hipSuccess) { fprintf(stderr, "kernel_launch: hipFuncSetAttribute failed\n"); grid = -1; return; }
        if (hipOccupancyMaxActiveBlocksPerMultiprocessor(&per_cu, (const void*)fwd_megakernel, 512, LDS_BYTES) != hipSuccess || per_cu < 1) { fprintf(stderr, "kernel_launch: occupancy query failed (%d)\n", per_cu); per_cu = 1; }
        (void)hipGetLastError();
        grid = cus * (per_cu > 1 ? 1 : per_cu);
        fprintf(stderr, "kernel_launch: cus %d per_cu %d grid %d\n", cus, per_cu, grid);
    }
    if (grid < 0) return;
    Ptrs p{};
    p.x = (const float*)d_in[0]; p.ret_w_in = (const float*)d_in[1]; p.ret_w_out = (const float*)d_in[2]; p.sb_w_kv = (const float*)d_in[3]; p.sb_w_q = (const float*)d_in[4];
    p.sb_w_out = (const float*)d_in[5]; p.ln_mix_g = (const float*)d_in[6]; p.ln_mix_b = (const float*)d_in[7]; p.ln_ffn_g = (const float*)d_in[8]; p.ln_ffn_b = (const float*)d_in[9];
    p.ffn_w_in = (const float*)d_in[10]; p.ffn_w_out = (const float*)d_in[11]; p.moe_w_router = (const float*)d_in[12]; p.moe_w_in = (const float*)d_in[13]; p.moe_w_out = (const float*)d_in[14];
    p.out = (float*)d_out; p.ws = (unsigned char*)d_ws;
    if (hipMemsetAsync((unsigned char*)d_ws + WS_CTL + 4096 * 4, 0, XCD_BAR_WORDS * 4, stream) != hipSuccess) { fprintf(stderr, "kernel_launch: hipMemsetAsync of the barrier words failed\n"); return; }
    void* args[] = {&p};
    hipError_t e = hipLaunchCooperativeKernel((const void*)fwd_megakernel, dim3(grid), dim3(512), args, LDS_BYTES, stream);
    if (e != hipSuccess) fprintf(stderr, "kernel_launch: cooperative launch failed: %s (grid %d)\n", hipGetErrorString(e), grid);
}
```

```cpp
#include <hip/hip_runtime.h>
#include <hip/hip_cooperative_groups.h>
#include <cstdio>
#include <cstdint>
namespace cg = cooperative_groups;
namespace pg8 {
#define PG8_LAS __attribute__((address_space(3)))
typedef unsigned short bf16_t;
typedef short bf16x8 __attribute__((ext_vector_type(8)));
typedef float f32x4 __attribute__((ext_vector_type(4)));
typedef unsigned u32x4 __attribute__((ext_vector_type(4)));
typedef unsigned u32x2 __attribute__((ext_vector_type(2)));
typedef int v4i_t __attribute__((ext_vector_type(4)));
typedef int v8i_t __attribute__((ext_vector_type(8)));
constexpr int BM = 256, BK = 64, HALF = 128, HTB = HALF * BK * 2  , STAGE_BYTES = 8 * HTB, NXCD = 8;
#ifndef WGM_DEFAULT
#define WGM_DEFAULT 2
#endif
#ifndef WGM_T
#define WGM_T 4
#endif

__host__ __device__ __forceinline__ int lds_byte(int r, int c) { const int st = (r >> 4) * 2 + (c >> 5), rr = r & 15, cc = c & 31, ob = rr * 64 + cc * 2; return st * 1024 + (ob ^ (((ob >> 9) & 1) << 5)); }
__host__ __device__ __forceinline__ void stage_rc(int b, int& R, int& C) { const int st = b / 1024, sb = b % 1024, swz = sb ^ (((sb >> 9) & 1) << 5); R = (st >> 1) * 16 + swz / 64; C = (st & 1) * 32 + (swz % 64) / 2; }
__host__ __device__ __forceinline__ int perm32(int rho) { const int n = rho >> 4, i = rho & 15; return 8 * (i >> 2) + 4 * n + (i & 3); }

struct Unit { int pm, pn; };
struct Gemm { const bf16_t* A; const bf16_t* Bt; int M, N, K; };

struct StaticOrder {
    int nM, nN, nwg, G, c, wgm;
    __host__ __device__ void init(int M, int N, int G_, int c_, int wgm_ = WGM_DEFAULT) { nM = M / BM; nN = N / BM; nwg = nM * nN; G = G_; c = c_; wgm = wgm_; }
    __host__ __device__ bool next(int i, Unit& u) const {
        const long L = (long)i * G + c; if (L >= nwg) return false;
        int wgid = (int)L; { const int q = nwg / NXCD, r = nwg % NXCD, xcd = wgid % NXCD, off = wgid / NXCD; wgid = (xcd < r ? xcd * (q + 1) : r * (q + 1) + (xcd - r) * q) + off; }
        const int nig = wgm * nN, gid = wgid / nig, fm = gid * wgm, gsz = (nM - fm) < wgm ? (nM - fm) : wgm;
        u.pm = fm + ((wgid % nig) % gsz); u.pn = (wgid % nig) / gsz; return true;
    }
    __device__ __forceinline__ void a_ready(const Unit&) const {}
    __device__ __forceinline__ void done(const Unit&) const {}
};

__device__ __forceinline__ float sat8(float v) { return __builtin_amdgcn_fmed3f(v, -448.0f, 448.0f); }
typedef float f32x2_t __attribute__((ext_vector_type(2)));
typedef __bf16 bf16x2_t __attribute__((ext_vector_type(2)));
__device__ __forceinline__ unsigned cvt_pk_bf16(float lo, float hi) { const f32x2_t v = {lo, hi}; const bf16x2_t b = __builtin_convertvector(v, bf16x2_t); return __builtin_bit_cast(unsigned, b); }

struct MoeOrder : StaticOrder {
    const int* tile_e; int NT;
    __device__ __forceinline__ bool next(int i, Unit& u) const {
        if (!StaticOrder::next(i, u)) return false;
        const int e = __builtin_amdgcn_readfirstlane(__hip_atomic_load(tile_e + u.pm, __ATOMIC_RELAXED, __HIP_MEMORY_SCOPE_AGENT));
        u.pn += e * NT; return true;
    }
};

struct EpiBf16Plain {
    static constexpr bool PERM = true, AFTER_DRAIN = false;
    bf16_t* O; int ldc; float sc; int ntmod;
    __device__ __forceinline__ void operator()(const f32x4 (&acc)[2][2][4][2], const Unit& u, int wr, int wc, int fr, int fq) const {
        const int row0 = u.pm * BM + wr * 64 + fr, col0 = (ntmod ? (u.pn % ntmod) : u.pn) * BM + wc * 32 + 8 * fq; const float scl = sc != 0.f ? sc : 1.0f;
#pragma unroll
        for (int ai = 0; ai < 2; ++ai)
#pragma unroll
            for (int m = 0; m < 4; ++m) { bf16_t* rowp = O + (size_t)(row0 + ai * HALF + m * 16) * ldc + col0;
#pragma unroll
                for (int bj = 0; bj < 2; ++bj) { const f32x4 v0 = acc[ai][bj][m][0] * scl, v1 = acc[ai][bj][m][1] * scl;
                    u32x4 w; w.x = cvt_pk_bf16(v0[0], v0[1]); w.y = cvt_pk_bf16(v0[2], v0[3]); w.z = cvt_pk_bf16(v1[0], v1[1]); w.w = cvt_pk_bf16(v1[2], v1[3]);
                    *(u32x4*)(rowp + bj * HALF) = w; } }
    }
};
struct EpiRetNat {
    static constexpr bool PERM = true, AFTER_DRAIN = false;
    bf16_t* QK; bf16_t* Gt; const float* cosN; const float* sinN; const float* kd;
    __device__ __forceinline__ void operator()(const f32x4 (&acc)[2][2][4][2], const Unit& u, int wr, int wc, int fr, int fq) const {
        const int row0 = u.pm * BM + wr * 64 + fr;
        if (u.pn >= 8) {
            const int col0 = (u.pn - 8) * BM + wc * 32 + 8 * fq;
#pragma unroll
            for (int ai = 0; ai < 2; ++ai)
#pragma unroll
                for (int m = 0; m < 4; ++m) { bf16_t* rowp = Gt + (size_t)(row0 + ai * HALF + m * 16) * 2048 + col0;
#pragma unroll
                    for (int bj = 0; bj < 2; ++bj) { const f32x4 v0 = acc[ai][bj][m][0], v1 = acc[ai][bj][m][1];
                        u32x4 w; w.x = cvt_pk_bf16(v0[0], v0[1]); w.y = cvt_pk_bf16(v0[2], v0[3]); w.z = cvt_pk_bf16(v1[0], v1[1]); w.w = cvt_pk_bf16(v1[2], v1[3]);
                        *(u32x4*)(rowp + bj * HALF) = w; } }
        } else {
            const int dcol = wc * 32 + 8 * fq;
#pragma unroll
            for (int ai = 0; ai < 2; ++ai)
#pragma unroll
                for (int m = 0; m < 4; ++m) { const int r = row0 + ai * HALF + m * 16, pos = r & 4095;
                    const float* cp = cosN + pos * 128 + dcol; const float* sp = sinN + pos * 128 + dcol;
                    const f32x4 c0 = *(const f32x4*)cp, c1 = *(const f32x4*)(cp + 4), s0 = *(const f32x4*)sp, s1 = *(const f32x4*)(sp + 4);
                    const f32x4 a0 = acc[ai][0][m][0], a1 = acc[ai][0][m][1], b0 = acc[ai][1][m][0], b1 = acc[ai][1][m][1];
                    const float kdv = (u.pn >= 4) ? kd[(u.pn - 4) * 64 + (pos & 63)] : 1.0f;
                    const f32x4 o10 = (a0 * c0 - b0 * s0) * kdv, o11 = (a1 * c1 - b1 * s1) * kdv, o20 = (a0 * s0 + b0 * c0) * kdv, o21 = (a1 * s1 + b1 * c1) * kdv;
                    bf16_t* rowp = QK + (size_t)r * 2048 + u.pn * BM + dcol;
                    u32x4 w; w.x = cvt_pk_bf16(o10[0], o10[1]); w.y = cvt_pk_bf16(o10[2], o10[3]); w.z = cvt_pk_bf16(o11[0], o11[1]); w.w = cvt_pk_bf16(o11[2], o11[3]);
                    *(u32x4*)rowp = w;
                    w.x = cvt_pk_bf16(o20[0], o20[1]); w.y = cvt_pk_bf16(o20[2], o20[3]); w.z = cvt_pk_bf16(o21[0], o21[1]); w.w = cvt_pk_bf16(o21[2], o21[3]);
                    *(u32x4*)(rowp + HALF) = w; }
        }
    }
};
struct EpiRetT {
    static constexpr bool PERM = true, AFTER_DRAIN = false;
    bf16_t* KVT; const float* cosT; const float* sinT; const float* kd;
    __device__ __forceinline__ void operator()(const f32x4 (&acc)[2][2][4][2], const Unit& u, int wr, int wc, int fr, int fq) const {
        const int col0 = u.pn * BM + wc * 32 + 8 * fq;
        if (u.pm >= 4) {
            const int row0 = u.pm * BM + wr * 64 + fr;
#pragma unroll
            for (int ai = 0; ai < 2; ++ai)
#pragma unroll
                for (int m = 0; m < 4; ++m) { bf16_t* rowp = KVT + (size_t)(row0 + ai * HALF + m * 16) * 16384 + col0;
#pragma unroll
                    for (int bj = 0; bj < 2; ++bj) { const f32x4 v0 = acc[ai][bj][m][0], v1 = acc[ai][bj][m][1];
                        u32x4 w; w.x = cvt_pk_bf16(v0[0], v0[1]); w.y = cvt_pk_bf16(v0[2], v0[3]); w.z = cvt_pk_bf16(v1[0], v1[1]); w.w = cvt_pk_bf16(v1[2], v1[3]);
                        *(u32x4*)(rowp + bj * HALF) = w; } }
        } else {
            const int h = u.pm;
#pragma unroll
            for (int m = 0; m < 4; ++m) { const int d = wr * 64 + m * 16 + fr;
#pragma unroll
                for (int bj = 0; bj < 2; ++bj) { const int c = col0 + bj * HALF, pos = c & 4095;
                    const float* cp = cosT + d * 4096 + pos; const float* sp = sinT + d * 4096 + pos; const float* kp = kd + h * 64 + (pos & 63);
                    const f32x4 c0 = *(const f32x4*)cp, c1 = *(const f32x4*)(cp + 4), s0 = *(const f32x4*)sp, s1 = *(const f32x4*)(sp + 4), k0 = *(const f32x4*)kp, k1 = *(const f32x4*)(kp + 4);
                    const f32x4 a0 = acc[0][bj][m][0], a1 = acc[0][bj][m][1], b0 = acc[1][bj][m][0], b1 = acc[1][bj][m][1];
                    const f32x4 o10 = (a0 * c0 - b0 * s0) * k0, o11 = (a1 * c1 - b1 * s1) * k1, o20 = (a0 * s0 + b0 * c0) * k0, o21 = (a1 * s1 + b1 * c1) * k1;
                    bf16_t* rowp = KVT + (size_t)(h * 256 + d) * 16384 + c;
                    u32x4 w; w.x = cvt_pk_bf16(o10[0], o10[1]); w.y = cvt_pk_bf16(o10[2], o10[3]); w.z = cvt_pk_bf16(o11[0], o11[1]); w.w = cvt_pk_bf16(o11[2], o11[3]);
                    *(u32x4*)rowp = w;
                    w.x = cvt_pk_bf16(o20[0], o20[1]); w.y = cvt_pk_bf16(o20[2], o20[3]); w.z = cvt_pk_bf16(o21[0], o21[1]); w.w = cvt_pk_bf16(o21[2], o21[3]);
                    *(u32x4*)(rowp + (size_t)HALF * 16384) = w; } }
        }
    }
};
struct EpiResF32 {
    static constexpr bool PERM = false, AFTER_DRAIN = false;
    const float* res; float* out; int ldc; float alpha; int ntmod; float sc;
    __device__ __forceinline__ void operator()(const f32x4 (&acc)[2][2][4][2], const Unit& u, int wr, int wc, int fr, int fq) const {
        const int pnl = ntmod ? (u.pn % ntmod) : u.pn;
        const int row0 = u.pm * BM + wr * 64 + fr, col0 = pnl * BM + wc * 32 + 4 * fq;
#pragma unroll
        for (int ai = 0; ai < 2; ++ai)
#pragma unroll
            for (int mp = 0; mp < 2; ++mp) {
                f32x4 rv[2][2][2];
                if (res) {
#pragma unroll
                    for (int mm = 0; mm < 2; ++mm) { const size_t off = (size_t)(row0 + ai * HALF + (2 * mp + mm) * 16) * ldc + col0;
#pragma unroll
                        for (int bj = 0; bj < 2; ++bj)
#pragma unroll
                            for (int n = 0; n < 2; ++n) rv[mm][bj][n] = *(const f32x4*)(res + off + bj * HALF + n * 16); }
                }
#pragma unroll
                for (int mm = 0; mm < 2; ++mm) { const int m = 2 * mp + mm; const size_t off = (size_t)(row0 + ai * HALF + m * 16) * ldc + col0;
#pragma unroll
                    for (int bj = 0; bj < 2; ++bj)
#pragma unroll
                        for (int n = 0; n < 2; ++n) { f32x4 o = acc[ai][bj][m][n] * sc;
                            if (res) o = o + rv[mm][bj][n] * alpha;
                            *(f32x4*)(out + off + bj * HALF + n * 16) = o; } }
                asm volatile("" ::: "memory");
            }
    }
};
struct EpiSwiglu {
    static constexpr bool PERM = true, AFTER_DRAIN = false;
    bf16_t* O; int ldc; int ntmod; float sc;
    float osc;
    __device__ __forceinline__ void operator()(const f32x4 (&acc)[2][2][4][2], const Unit& u, int wr, int wc, int fr, int fq) const {
        typedef float f32x2v __attribute__((ext_vector_type(2)));
        const int pnl = ntmod ? (u.pn % ntmod) : u.pn;
        const int row0 = u.pm * BM + wr * 64 + fr, col0 = pnl * HALF + wc * 32 + 8 * fq;
        const float c1 = -sc * 1.4426950408889634f, c2 = sc * sc * (osc != 0.f ? osc : 1.0f);
#pragma unroll
        for (int ai = 0; ai < 2; ++ai)
#pragma unroll
            for (int m = 0; m < 4; ++m) {
                f32x2v hv[2][2];
#pragma unroll
                for (int n = 0; n < 2; ++n) { const f32x4 g = acc[ai][0][m][n], up = acc[ai][1][m][n];
#pragma unroll
                    for (int jp = 0; jp < 2; ++jp) { const f32x2v g2 = (f32x2v){g[2 * jp], g[2 * jp + 1]}, u2 = (f32x2v){up[2 * jp], up[2 * jp + 1]};
                        const f32x2v a = g2 * c1; f32x2v t; t.x = __builtin_amdgcn_exp2f(a.x); t.y = __builtin_amdgcn_exp2f(a.y);
                        const f32x2v d = t + 1.0f; f32x2v r; r.x = __builtin_amdgcn_rcpf(d.x); r.y = __builtin_amdgcn_rcpf(d.y);
                        hv[n][jp] = ((g2 * u2) * r) * c2; } }
                if (osc != 0.f) { u32x2 w8;
                    int t0 = __builtin_amdgcn_cvt_pk_fp8_f32(sat8(hv[0][0].x), sat8(hv[0][0].y), 0, false); t0 = __builtin_amdgcn_cvt_pk_fp8_f32(sat8(hv[0][1].x), sat8(hv[0][1].y), t0, true);
                    int t1 = __builtin_amdgcn_cvt_pk_fp8_f32(sat8(hv[1][0].x), sat8(hv[1][0].y), 0, false); t1 = __builtin_amdgcn_cvt_pk_fp8_f32(sat8(hv[1][1].x), sat8(hv[1][1].y), t1, true);
                    w8.x = (unsigned)t0; w8.y = (unsigned)t1; *(u32x2*)((unsigned char*)O + (size_t)(row0 + ai * HALF + m * 16) * ldc + col0) = w8; }
                else { bf16_t* rowp = O + (size_t)(row0 + ai * HALF + m * 16) * ldc + col0;
                    u32x4 w; w.x = cvt_pk_bf16(hv[0][0].x, hv[0][0].y); w.y = cvt_pk_bf16(hv[0][1].x, hv[0][1].y); w.z = cvt_pk_bf16(hv[1][0].x, hv[1][0].y); w.w = cvt_pk_bf16(hv[1][1].x, hv[1][1].y);
                    *(u32x4*)rowp = w; }
            }
    }
};

template <class Epi, class Sched, bool ALIGN_EPI = false, bool SP2 = false, bool FP8 = false>
__device__ __forceinline__ void gemm_phase(PG8_LAS unsigned char* lds, const Gemm g, const Sched& S, const Epi& E) {
    int tid_ = threadIdx.x; asm volatile("" : "+v"(tid_));
    const int tid = tid_, wid = __builtin_amdgcn_readfirstlane(tid >> 6), lane = tid & 63, wr = wid >> 2, wc = wid & 3, fr = lane & 15, fq = lane >> 4;
    const int K = g.K, Kb = FP8 ? K : 2 * K, nt = Kb / 128;
    unsigned voffA[2], voffB[2];
#pragma unroll
    for (int i = 0; i < 2; ++i) { int R, C; stage_rc(tid * 16 + i * 8192, R, C); const int Rb = Epi::PERM ? ((R & ~31) + perm32(R & 31)) : R;
        voffA[i] = (unsigned)(R * Kb + 2 * C); voffB[i] = (unsigned)(Rb * Kb + 2 * C); }
    const size_t kstep = (size_t)(BK * 2);
    const size_t hstep = (size_t)HALF * Kb;
    const size_t tstep = 2 * hstep;
    const unsigned ldsw = (unsigned)wid * 1024u;
    const int aoff = FP8 ? lds_byte(wr * 64 + fr, fq * 16) : lds_byte(wr * 64 + fr, fq * 8), boff = FP8 ? lds_byte(wc * 32 + fr, fq * 16) : lds_byte(wc * 32 + fr, fq * 8);
    int abase = aoff, bbase = boff + 4 * HTB; asm volatile("" : "+v"(abase), "+v"(bbase));
    constexpr int PIECE = FP8 ? 16 : 1024;
#define PG8_SA(b, h) (((b) * 2 + (h)) * HTB)
#define PG8_SB(b, h) ((4 + (b) * 2 + (h)) * HTB)
#define PG8_STAGE(bufoff, gbase, voff) do { _Pragma("unroll") for (int _i = 0; _i < 2; ++_i) \
        __builtin_amdgcn_global_load_lds((const unsigned*)((const char*)(gbase) + (voff)[_i]), (PG8_LAS unsigned*)(lds + (bufoff) + ldsw + _i * 8192), 16, 0, 0); } while (0)
#define PG8_LDA(dst, b, h) do { _Pragma("unroll") for (int m = 0; m < 4; ++m) _Pragma("unroll") for (int k = 0; k < 2; ++k) dst[m][k] = *(const PG8_LAS bf16x8*)(lds + abase + (PG8_SA(b, h) + m * 2048 + k * PIECE)); } while (0)
#define PG8_LDB(dst, b, h) do { _Pragma("unroll") for (int n = 0; n < 2; ++n) _Pragma("unroll") for (int k = 0; k < 2; ++k) dst[n][k] = *(const PG8_LAS bf16x8*)(lds + bbase + (PG8_SB(b, h) - 4 * HTB + n * 2048 + k * PIECE)); } while (0)
#define PG8_MMA(ai, bj, At, Bt) do { __builtin_amdgcn_s_setprio(1); _Pragma("unroll") for (int m = 0; m < 4; ++m) _Pragma("unroll") for (int n = 0; n < 2; ++n) { \
        if constexpr (FP8) { const v8i_t a_ = __builtin_shufflevector(__builtin_bit_cast(v4i_t, At[m][0]), __builtin_bit_cast(v4i_t, At[m][1]), 0, 1, 2, 3, 4, 5, 6, 7), b_ = __builtin_shufflevector(__builtin_bit_cast(v4i_t, Bt[n][0]), __builtin_bit_cast(v4i_t, Bt[n][1]), 0, 1, 2, 3, 4, 5, 6, 7); \
            asm volatile("v_mfma_f32_16x16x128_f8f6f4 %0, %1, %2, %0" : "+v"(acc[ai][bj][m][n]) : "v"(b_), "v"(a_)); } \
        else { _Pragma("unroll") for (int k = 0; k < 2; ++k) acc[ai][bj][m][n] = __builtin_amdgcn_mfma_f32_16x16x32_bf16(Bt[n][k], At[m][k], acc[ai][bj][m][n], 0, 0, 0); } } \
        __builtin_amdgcn_s_setprio(0); } while (0)
#define PG8_WAIT_V(n) asm volatile("s_waitcnt vmcnt(" #n ")" ::: "memory")
#define PG8_WAIT_L(n) asm volatile("s_waitcnt lgkmcnt(" #n ")" ::: "memory")
#define PG8_BAR __builtin_amdgcn_s_barrier()
#define PG8_SCHED __builtin_amdgcn_sched_barrier(0)
    Unit cur, nxt; int ui = 0;
    if (!S.next(0, cur)) return;
    f32x4 acc[2][2][4][2];
#pragma unroll
    for (int a = 0; a < 2; ++a)
#pragma unroll
        for (int b = 0; b < 2; ++b)
#pragma unroll
            for (int m = 0; m < 4; ++m)
#pragma unroll
                for (int n = 0; n < 2; ++n) acc[a][b][m][n] = (f32x4){0.f, 0.f, 0.f, 0.f};
    bf16x8 At[4][2], B0[2][2], B1[2][2];
    const char* cA = (const char*)g.A + (size_t)cur.pm * tstep; const char* cB = (const char*)g.Bt + (size_t)cur.pn * tstep;
    S.a_ready(cur);
    if constexpr (SP2) {
        PG8_STAGE(PG8_SB(0, 0), cB, voffB); PG8_STAGE(PG8_SB(0, 1), cB + hstep, voffB); PG8_STAGE(PG8_SA(0, 0), cA, voffA); PG8_STAGE(PG8_SA(0, 1), cA + hstep, voffA);
        if (wr == 1) PG8_BAR;
        PG8_WAIT_V(2); PG8_BAR;
        PG8_STAGE(PG8_SB(1, 0), cB + kstep, voffB); PG8_STAGE(PG8_SA(1, 0), cA + kstep, voffA); PG8_STAGE(PG8_SB(1, 1), cB + hstep + kstep, voffB);
        PG8_WAIT_V(6); PG8_BAR;
    } else {
        PG8_STAGE(PG8_SB(0, 0), cB, voffB); PG8_STAGE(PG8_SA(0, 0), cA, voffA); PG8_STAGE(PG8_SB(0, 1), cB + hstep, voffB); PG8_STAGE(PG8_SA(0, 1), cA + hstep, voffA);
        if (wr == 1) PG8_BAR;
        PG8_WAIT_V(4); PG8_BAR;
        PG8_STAGE(PG8_SB(1, 0), cB + kstep, voffB); PG8_STAGE(PG8_SA(1, 0), cA + kstep, voffA); PG8_STAGE(PG8_SB(1, 1), cB + hstep + kstep, voffB);
        PG8_WAIT_V(6); PG8_BAR;
    }
    for (;;) {
        const bool has_next = S.next(ui + 1, nxt);
        const char* nA = has_next ? (const char*)g.A + (size_t)nxt.pm * tstep : cA; const char* nB = has_next ? (const char*)g.Bt + (size_t)nxt.pn * tstep : cB;
#pragma nounroll
        for (int t = 0; t < nt; t += 2) {
            const bool last = (t == nt - 2);
            asm volatile("" : "+v"(voffA[0]), "+v"(voffA[1]), "+v"(voffB[0]), "+v"(voffB[1]));
            const char* a1 = cA + (size_t)(t + 1) * kstep;
            const char* a2 = last ? nA : cA + (size_t)(t + 2) * kstep; const char* b2 = last ? nB : cB + (size_t)(t + 2) * kstep;
            const char* a3 = a2 + kstep; const char* b3 = b2 + kstep;
            if (last && has_next) S.a_ready(nxt);
            if constexpr (SP2) {
            PG8_LDB(B0, 0, 0); PG8_LDB(B1, 0, 1); PG8_SCHED; PG8_LDA(At, 0, 0); PG8_STAGE(PG8_SA(1, 1), a1 + hstep, voffA);
            PG8_WAIT_V(8); PG8_WAIT_L(0); PG8_BAR; PG8_MMA(0, 0, At, B0); PG8_MMA(0, 1, At, B1); PG8_BAR; PG8_SCHED;
            PG8_LDA(At, 0, 1); PG8_STAGE(PG8_SB(0, 0), b2, voffB); PG8_STAGE(PG8_SB(0, 1), b2 + hstep, voffB); PG8_STAGE(PG8_SA(0, 0), a2, voffA);
            PG8_WAIT_V(8); PG8_WAIT_L(0); PG8_BAR; PG8_MMA(1, 0, At, B0); PG8_MMA(1, 1, At, B1); PG8_BAR; PG8_SCHED;
            PG8_LDB(B0, 1, 0); PG8_LDB(B1, 1, 1); PG8_SCHED; PG8_LDA(At, 1, 0); PG8_STAGE(PG8_SA(0, 1), a2 + hstep, voffA);
            PG8_WAIT_V(8); PG8_WAIT_L(0); PG8_BAR; PG8_MMA(0, 0, At, B0); PG8_MMA(0, 1, At, B1); PG8_BAR; PG8_SCHED;
            PG8_LDA(At, 1, 1); PG8_STAGE(PG8_SB(1, 0), b3, voffB); PG8_STAGE(PG8_SB(1, 1), b3 + hstep, voffB); PG8_STAGE(PG8_SA(1, 0), a3, voffA);
            PG8_WAIT_V(8); PG8_WAIT_L(0); PG8_BAR; PG8_MMA(1, 0, At, B0); PG8_MMA(1, 1, At, B1); PG8_BAR; PG8_SCHED;
            } else {
            PG8_LDB(B0, 0, 0); PG8_SCHED; PG8_LDA(At, 0, 0); PG8_STAGE(PG8_SA(1, 1), a1 + hstep, voffA);
            PG8_WAIT_L(8); PG8_BAR; PG8_WAIT_L(0); PG8_MMA(0, 0, At, B0); PG8_BAR; PG8_SCHED;
            PG8_LDB(B1, 0, 1); PG8_STAGE(PG8_SB(0, 0), b2, voffB);
            PG8_BAR; PG8_WAIT_L(0); PG8_MMA(0, 1, At, B1); PG8_BAR;
            PG8_LDA(At, 0, 1); PG8_STAGE(PG8_SA(0, 0), a2, voffA);
            PG8_BAR; PG8_WAIT_L(0); PG8_MMA(1, 0, At, B0); PG8_BAR; PG8_SCHED;
            PG8_STAGE(PG8_SB(0, 1), b2 + hstep, voffB);
            PG8_WAIT_V(6); PG8_BAR; PG8_MMA(1, 1, At, B1); PG8_BAR;
            PG8_LDB(B0, 1, 0); PG8_SCHED; PG8_LDA(At, 1, 0); PG8_STAGE(PG8_SA(0, 1), a2 + hstep, voffA);
            PG8_WAIT_L(8); PG8_BAR; PG8_WAIT_L(0); PG8_MMA(0, 0, At, B0); PG8_BAR; PG8_SCHED;
            PG8_LDB(B1, 1, 1); PG8_STAGE(PG8_SB(1, 0), b3, voffB);
            PG8_BAR; PG8_WAIT_L(0); PG8_MMA(0, 1, At, B1); PG8_BAR;
            PG8_LDA(At, 1, 1); PG8_STAGE(PG8_SA(1, 0), a3, voffA);
            PG8_BAR; PG8_WAIT_L(0); PG8_MMA(1, 0, At, B0); PG8_BAR; PG8_SCHED;
            PG8_STAGE(PG8_SB(1, 1), b3 + hstep, voffB);
            PG8_WAIT_V(6); PG8_BAR; PG8_MMA(1, 1, At, B1); PG8_BAR;
            }
        }
        if constexpr (FP8) asm volatile("s_nop 15\n\ts_nop 15" ::: "memory");
        if constexpr (ALIGN_EPI) { if (wr == 0) PG8_BAR; }
        if constexpr (!Epi::AFTER_DRAIN) { E(acc, cur, wr, wc, fr, fq); S.done(cur); }
        if (!has_next) break;
#pragma unroll
        for (int a = 0; a < 2; ++a)
#pragma unroll
            for (int b = 0; b < 2; ++b)
#pragma unroll
                for (int m = 0; m < 4; ++m)
#pragma unroll
                    for (int n = 0; n < 2; ++n) acc[a][b][m][n] = (f32x4){0.f, 0.f, 0.f, 0.f};
        cur = nxt; cA = nA; cB = nB; ++ui;
        if constexpr (ALIGN_EPI) { if (wr == 1) PG8_BAR; }
    }
    PG8_WAIT_V(0);
    if constexpr (!ALIGN_EPI) { if (wr == 0) PG8_BAR; }
    PG8_BAR;
    if constexpr (Epi::AFTER_DRAIN) { E.fused(acc, cur, wr, wc, fr, fq, lds, wid, lane); S.done(cur); }
#undef PG8_SA
#undef PG8_SB
#undef PG8_STAGE
#undef PG8_LDA
#undef PG8_LDB
#undef PG8_MMA
#undef PG8_WAIT_V
#undef PG8_WAIT_L
#undef PG8_BAR
#undef PG8_SCHED
}
}


#define LAS __attribute__((address_space(3)))
typedef unsigned short bf16;
typedef unsigned u32x4 __attribute__((ext_vector_type(4)));
typedef unsigned u32x2 __attribute__((ext_vector_type(2)));
typedef float f32x4 __attribute__((ext_vector_type(4)));
typedef short bf16x8 __attribute__((ext_vector_type(8)));
typedef short s16x4_t __attribute__((ext_vector_type(4)));
using pg8::cvt_pk_bf16;

constexpr int NTOK = 16384, DM = 1024, SEQ = 4096;
constexpr int DFF = 2816, DEXP = 3584, NEXP = 8;
constexpr float ALPHA = 1.4142135623730951f;
constexpr float LN_EPS = 1e-5f;
constexpr int RMAX = 32768 + 8 * 256;
constexpr int LDS_BYTES = 143360;
constexpr float W6_SCALE = 32.0f, W7_SCALE = 64.0f, H_SCALE = 16.0f;
constexpr float W14_SCALE = 64.0f, H2_SCALE = 16.0f;
constexpr float W13_SCALE = 32.0f;

constexpr size_t MiB = 1u << 20;
constexpr size_t WS_CTL = 0;
constexpr size_t WS_ROPE = 1 * MiB;
constexpr size_t WS_ROUTE = 9 * MiB;
constexpr size_t WS_W1A = 16 * MiB, WS_W1B = 24 * MiB, WS_W4 = 30 * MiB, WS_W9A = 34 * MiB, WS_W9B = 38 * MiB, WS_W11 = 40 * MiB,
                 WS_W6 = 42 * MiB, WS_W7 = 53 * MiB, WS_W13 = 59 * MiB, WS_W14 = 171 * MiB;
constexpr size_t WS_XB = 228 * MiB, WS_XF = 260 * MiB, WS_Y = 324 * MiB, WS_RA = 388 * MiB, WS_RB = 644 * MiB, WS_END = 788 * MiB;

__device__ __forceinline__ int opq(int v) { asm volatile("" : "+v"(v)); return v; }
__device__ __forceinline__ float wave_sum(float v) {
#pragma unroll
    for (int o = 1; o < 64; o <<= 1) v += __shfl_xor(v, o);
    return v;
}
__device__ __forceinline__ float bf2f(unsigned short b) { return __uint_as_float(((unsigned)b) << 16); }
__device__ __forceinline__ void unpack8(const u32x4 v, float* f) {
    f[0] = __uint_as_float(v.x << 16); f[1] = __uint_as_float(v.x & 0xffff0000u); f[2] = __uint_as_float(v.y << 16); f[3] = __uint_as_float(v.y & 0xffff0000u);
    f[4] = __uint_as_float(v.z << 16); f[5] = __uint_as_float(v.z & 0xffff0000u); f[6] = __uint_as_float(v.w << 16); f[7] = __uint_as_float(v.w & 0xffff0000u);
}

#define RLX_AGENT __ATOMIC_RELAXED, __HIP_MEMORY_SCOPE_AGENT
#define XB_TMO      128
#define XB_XCNT(j)  (256  + 64 * (j))
#define XB_XSUB(j)  (1280 + 64 * (j))
#define XB_XGEN(j)  (2304 + 64 * (j))
#define XB_TOP      3328
#define XB_TOPGEN   3392
#define XCD_BAR_WORDS 3456
#define XB_SPIN_CAP (1u << 18)

__device__ __forceinline__ unsigned xb_ld(unsigned* p)              { return __hip_atomic_load(p, __ATOMIC_RELAXED, __HIP_MEMORY_SCOPE_AGENT); }
__device__ __forceinline__ unsigned xb_add(unsigned* p, unsigned v) { return __hip_atomic_fetch_add(p, v, __ATOMIC_RELAXED, __HIP_MEMORY_SCOPE_AGENT); }
__device__ __forceinline__ unsigned xb_xcc_id() { return (unsigned)__builtin_amdgcn_s_getreg((3 << 11) | 20) & 0xFu; }
#define XB_SPIN(cond, bar) do { unsigned _sp = 0; while (cond) { __builtin_amdgcn_s_sleep(1); \
    if ((++_sp & 255u) == 0u) { if (xb_ld(&(bar)[XB_TMO])) break; if (_sp > XB_SPIN_CAP) { atomicAdd(&(bar)[XB_TMO], 1u); break; } } } } while (0)

struct XcdBarrier {
    unsigned* bar; unsigned x;
    volatile LAS unsigned* st;
};

__device__ __forceinline__ XcdBarrier xcd_barrier_post(unsigned* bar, volatile LAS unsigned* st) {
    XcdBarrier b; b.bar = bar; b.x = xb_xcc_id(); b.st = st;
    if (threadIdx.x == 0) (void)xb_add(&bar[XB_XCNT(b.x)], 1u);
    return b;
}
__device__ __forceinline__ void xcd_barrier_complete(unsigned* bar, unsigned x, unsigned& nloc, unsigned& nx) {
    const unsigned G = gridDim.x * gridDim.y * gridDim.z;
    unsigned sum, cnt, mine, sp = 0u;
    for (;;) {
        sum = 0u; cnt = 0u; mine = 0u;
#pragma unroll
        for (unsigned j = 0; j < 16; ++j) { const unsigned c = xb_ld(&bar[XB_XCNT(j)]); sum += c; cnt += (c > 0u) ? 1u : 0u; mine = (j == x) ? c : mine; }
        if (sum == G) break;
        __builtin_amdgcn_s_sleep(1);
        if ((++sp & 255u) == 0u) { if (xb_ld(&bar[XB_TMO])) break; if (sp > XB_SPIN_CAP) { atomicAdd(&bar[XB_TMO], 1u); break; } }
    }
    nloc = mine > 0u ? mine : 1u; nx = cnt > 0u ? cnt : 1u;
}

__device__ __forceinline__ void xcd_barrier(const XcdBarrier& b) {
    asm volatile("s_waitcnt vmcnt(0)" ::: "memory");
    __syncthreads();
    if (threadIdx.x == 0) {
        unsigned* bar = b.bar;
        __builtin_amdgcn_s_waitcnt(0);
        unsigned nloc = b.st[0], nx = b.st[1];
        if (nloc == 0u) { xcd_barrier_complete(bar, b.x, nloc, nx); b.st[0] = nloc; b.st[1] = nx; }
        const unsigned old = xb_add(&bar[XB_XSUB(b.x)], 1u);
        const unsigned gen = old / nloc;
        if (old + 1u == (gen + 1u) * nloc) {
            __builtin_amdgcn_fence(__ATOMIC_RELEASE, "agent");
            asm volatile("s_waitcnt vmcnt(0)" ::: "memory");
            const unsigned og = xb_add(&bar[XB_TOP], 1u);
            const unsigned tg = og / nx;
            if (og + 1u == (tg + 1u) * nx) xb_add(&bar[XB_TOPGEN], 1u);
            else XB_SPIN(xb_ld(&bar[XB_TOPGEN]) == tg, bar);
            __builtin_amdgcn_fence(__ATOMIC_ACQUIRE, "agent");
            xb_add(&bar[XB_XGEN(b.x)], 1u);
            asm volatile("s_waitcnt vmcnt(0)" ::: "memory");
        } else {
            XB_SPIN(xb_ld(&bar[XB_XGEN(b.x)]) == gen, bar);
            __builtin_amdgcn_fence(__ATOMIC_ACQUIRE, "agent");
            asm volatile("s_waitcnt vmcnt(0)" ::: "memory");
        }
    }
    __syncthreads();
}


__device__ __forceinline__ void tr_tile(const float* W, int N, int K, bf16* d1, bf16* d2, float scale, LAS float* scr, int lane) {
    f32x4 v[16];
    const float* src = W + (size_t)(lane >> 4) * N + 4 * (lane & 15);
#pragma unroll
    for (int it = 0; it < 16; ++it) v[it] = __builtin_nontemporal_load((const f32x4*)(src + (size_t)(4 * it) * N));
#pragma unroll
    for (int it = 0; it < 16; ++it) { LAS float* p = scr + (4 * it + (lane >> 4)) * 65 + 4 * (lane & 15);
        p[0] = v[it][0] * scale; p[1] = v[it][1] * scale; p[2] = v[it][2] * scale; p[3] = v[it][3] * scale; }
    asm volatile("s_waitcnt lgkmcnt(0)" ::: "memory");
    const int c = lane & 7;
#pragma unroll
    for (int jj = 0; jj < 8; ++jj) { const int n = (lane >> 3) + 8 * jj; const LAS float* s = scr + (8 * c) * 65 + n;
        u32x4 o; o.x = cvt_pk_bf16(s[0], s[65]); o.y = cvt_pk_bf16(s[2 * 65], s[3 * 65]); o.z = cvt_pk_bf16(s[4 * 65], s[5 * 65]); o.w = cvt_pk_bf16(s[6 * 65], s[7 * 65]);
        *(u32x4*)(d1 + (size_t)n * K + 8 * c) = o;
        if (d2) *(u32x4*)(d2 + (size_t)n * K + 8 * c) = o; }
    asm volatile("s_waitcnt lgkmcnt(0)" ::: "memory");
}
__device__ __forceinline__ int swi_row(int n0, int F) { return n0 < F ? (n0 >> 7) * 256 + (n0 & 127) : ((n0 - F) >> 7) * 256 + 128 + ((n0 - F) & 127); }

__device__ __forceinline__ void tr_tile_f8(const float* W, int N, int K, unsigned char* d1, float scale, LAS float* scr, int lane) {
    f32x4 v[16];
    const float* src = W + (size_t)(lane >> 4) * N + 4 * (lane & 15);
#pragma unroll
    for (int it = 0; it < 16; ++it) v[it] = __builtin_nontemporal_load((const f32x4*)(src + (size_t)(4 * it) * N));
#pragma unroll
    for (int it = 0; it < 16; ++it) { LAS float* p = scr + (4 * it + (lane >> 4)) * 65 + 4 * (lane & 15);
        p[0] = v[it][0] * scale; p[1] = v[it][1] * scale; p[2] = v[it][2] * scale; p[3] = v[it][3] * scale; }
    asm volatile("s_waitcnt lgkmcnt(0)" ::: "memory");
    const int c = lane & 3;
#pragma unroll
    for (int jj = 0; jj < 4; ++jj) { const int n = (lane >> 2) + 16 * jj; const LAS float* s = scr + (16 * c) * 65 + n;
        u32x4 o;
#pragma unroll
        for (int q = 0; q < 4; ++q) { int w = __builtin_amdgcn_cvt_pk_fp8_f32(pg8::sat8(s[(4 * q) * 65]), pg8::sat8(s[(4 * q + 1) * 65]), 0, false);
            w = __builtin_amdgcn_cvt_pk_fp8_f32(pg8::sat8(s[(4 * q + 2) * 65]), pg8::sat8(s[(4 * q + 3) * 65]), w, true); o[q] = (unsigned)w; }
        *(u32x4*)(d1 + (size_t)n * K + 16 * c) = o; }
    asm volatile("s_waitcnt lgkmcnt(0)" ::: "memory");
}
struct Ptrs {
    const float* x; const float* ret_w_in; const float* ret_w_out; const float* sb_w_kv; const float* sb_w_q; const float* sb_w_out;
    const float* ln_mix_g; const float* ln_mix_b; const float* ln_ffn_g; const float* ln_ffn_b; const float* ffn_w_in; const float* ffn_w_out;
    const float* moe_w_router; const float* moe_w_in; const float* moe_w_out;
    float* out; unsigned char* ws;
};

__device__ __forceinline__ void phase0(const Ptrs& P, LAS unsigned char* lds, int gw, int NGW, int lane, int gtid, int NT) {
    unsigned char* ws = P.ws;
    LAS float* scr = (LAS float*)(lds + (threadIdx.x >> 6) * 16640);
    constexpr int I0 = 16 * 96, I1 = 32 * 16, I2 = 16 * 32, I3 = 16 * 16, I4 = 16 * 16, I5 = 16 * 88, I6 = 44 * 16, I7 = 8 * 16 * 112, I8 = 8 * 56 * 16;
    constexpr int NITEMS = I0 + I1 + I2 + I3 + I4 + I5 + I6 + I7 + I8;
    for (int it = gw; it < NITEMS; it += NGW) {
        int r = it;
        if (r < I0) { const int kb = r / 96, nb = r % 96, k0 = kb * 64, n0 = nb * 64; const float* src = P.ret_w_in + (size_t)k0 * 6144 + n0;
            bf16 *d1, *d2 = nullptr; float sc = 1.f;
            if (n0 < 1024) d1 = (bf16*)(ws + WS_W1A) + (size_t)n0 * 1024 + k0;
            else if (n0 < 2048) { d1 = (bf16*)(ws + WS_W1A) + (size_t)n0 * 1024 + k0; sc = 0.0625f; }
            else if (n0 < 4096) d1 = (bf16*)(ws + WS_W1B) + (size_t)(n0 - 2048) * 1024 + k0;
            else d1 = (bf16*)(ws + WS_W1A) + (size_t)(n0 - 2048) * 1024 + k0;
            tr_tile(src, 6144, 1024, d1, d2, sc, scr, lane); continue; } r -= I0;
        if (r < I1) { const int kb = r / 16, nb = r % 16, k0 = kb * 64, n0 = nb * 64;
            tr_tile(P.ret_w_out + (size_t)k0 * 1024 + n0, 1024, 2048, (bf16*)(ws + WS_W4) + (size_t)n0 * 2048 + k0, nullptr, 1.f, scr, lane); continue; } r -= I1;
        if (r < I2) { const int kb = r / 32, nb = r % 32, k0 = kb * 64, n0 = nb * 64;
            bf16* d1 = n0 < 1024 ? (bf16*)(ws + WS_W9A) + (size_t)n0 * 1024 + k0 : (bf16*)(ws + WS_W9B) + (size_t)(n0 - 1024) * 1024 + k0;
            tr_tile(P.sb_w_kv + (size_t)k0 * 2048 + n0, 2048, 1024, d1, nullptr, 1.f, scr, lane); continue; } r -= I2;
        if (r < I3) { const int kb = r / 16, nb = r % 16, k0 = kb * 64, n0 = nb * 64;
            tr_tile(P.sb_w_q + (size_t)k0 * 1024 + n0, 1024, 1024, (bf16*)(ws + WS_W9A) + (size_t)(1024 + n0) * 1024 + k0, nullptr, 0.125f * 1.4426950408889634f, scr, lane); continue; } r -= I3;
        if (r < I4) { const int kb = r / 16, nb = r % 16, k0 = kb * 64, n0 = nb * 64;
            tr_tile(P.sb_w_out + (size_t)k0 * 1024 + n0, 1024, 1024, (bf16*)(ws + WS_W11) + (size_t)n0 * 1024 + k0, nullptr, 1.f, scr, lane); continue; } r -= I4;
        if (r < I5) { const int kb = r / 88, nb = r % 88, k0 = kb * 64, n0 = nb * 64;
            tr_tile_f8(P.ffn_w_in + (size_t)k0 * 5632 + n0, 5632, 1024, (unsigned char*)(ws + WS_W6) + (size_t)swi_row(n0, DFF) * 1024 + k0, W6_SCALE, scr, lane); continue; } r -= I5;
        if (r < I6) { const int kb = r / 16, nb = r % 16, k0 = kb * 64, n0 = nb * 64;
            tr_tile_f8(P.ffn_w_out + (size_t)k0 * 1024 + n0, 1024, DFF, (unsigned char*)(ws + WS_W7) + (size_t)n0 * DFF + k0, W7_SCALE, scr, lane); continue; } r -= I6;
        if (r < I7) { const int e = r / (16 * 112), q = r % (16 * 112), kb = q / 112, nb = q % 112, k0 = kb * 64, n0 = nb * 64;
            tr_tile_f8(P.moe_w_in + (size_t)e * 1024 * 7168 + (size_t)k0 * 7168 + n0, 7168, 1024, (unsigned char*)(ws + WS_W13) + ((size_t)e * 7168 + swi_row(n0, DEXP)) * 1024 + k0, W13_SCALE, scr, lane); continue; } r -= I7;
        { const int e = r / (56 * 16), q = r % (56 * 16), kb = q / 16, nb = q % 16, k0 = kb * 64, n0 = nb * 64;
            tr_tile_f8(P.moe_w_out + (size_t)e * DEXP * 1024 + (size_t)k0 * 1024 + n0, 1024, DEXP, (unsigned char*)(ws + WS_W14) + ((size_t)e * 1024 + n0) * DEXP + k0, W14_SCALE, scr, lane); }
    }
    { const f32x4* xs = (const f32x4*)P.x; u32x4* xd = (u32x4*)(ws + WS_XB);
      for (int i = gtid; i < NTOK * DM / 8; i += NT) { const f32x4 a = xs[2 * i], b = xs[2 * i + 1];
          u32x4 o; o.x = cvt_pk_bf16(a[0], a[1]); o.y = cvt_pk_bf16(a[2], a[3]); o.z = cvt_pk_bf16(b[0], b[1]); o.w = cvt_pk_bf16(b[2], b[3]); xd[i] = o; } }
    { float* cosN = (float*)(ws + WS_ROPE); float* sinN = cosN + 4096 * 128; float* cosT = sinN + 4096 * 128; float* sinT = cosT + 4096 * 128;
      for (int i = gtid; i < 4096 * 128; i += NT) { const int pos = i >> 7, f = i & 127;
          const float inv = (float)(1.0 / pow(10000.0, (double)(2 * f) / 256.0));
          const float ang = (float)pos * inv;
          const double a = (double)ang; const float c = (float)cos(a), s = (float)sin(a);
          cosN[i] = c; sinN[i] = s; } }
    if (blockIdx.x == 0) {
        int* ctl = (int*)(ws + WS_CTL);
        if (threadIdx.x < 32) ctl[threadIdx.x] = 0;
        if (threadIdx.x < 256) { const int h = threadIdx.x >> 6, m = threadIdx.x & 63;
            const float lg = logf(1.0f - exp2f(-5.0f - (float)h));
            ((float*)(ws + WS_CTL))[1024 + threadIdx.x] = expf(lg * (float)(63 - m)); }
    }
}


__device__ __forceinline__ void ret_scores_phase(LAS unsigned char* lds, const bf16* QK, bf16* PB, int vcu, int G) {
    int tid_ = threadIdx.x; asm volatile("" : "+v"(tid_));
    const int tid = tid_, lane = tid & 63, w = __builtin_amdgcn_readfirstlane(tid >> 6), fr = lane & 15, fq = lane >> 4;
    const int nb = w & 3, mbase = (w >> 2) * 2;
    constexpr int QS = 0, KS = 33792;
    u32x4 rq[4], rk[4];
#define SC_LOAD(uu) do { const int bh_ = (uu) >> 6, ch_ = (uu) & 63; const bf16* g_ = QK + ((size_t)(bh_ >> 2) * SEQ + ch_ * 64 + (tid >> 5)) * 2048 + (bh_ & 3) * 256 + (tid & 31) * 8; \
        _Pragma("unroll") for (int k = 0; k < 4; ++k) { rq[k] = *(const u32x4*)(g_ + (size_t)(16 * k) * 2048); rk[k] = *(const u32x4*)(g_ + (size_t)(16 * k) * 2048 + 1024); } } while (0)
    if (vcu < 1024) SC_LOAD(vcu);
    for (int u = vcu; u < 1024; u += G) {
        const int bh = u >> 6, h = bh & 3;
        const float lg2 = log2f(1.0f - exp2f(-5.0f - (float)h));
        __syncthreads();
#pragma unroll
        for (int k = 0; k < 4; ++k) {
            *(LAS u32x4*)(lds + QS + ((tid >> 5) + 16 * k) * 528 + (tid & 31) * 16) = rq[k];
            *(LAS u32x4*)(lds + KS + ((tid >> 5) + 16 * k) * 528 + (tid & 31) * 16) = rk[k]; }
        if (u + G < 1024) SC_LOAD(u + G);
        __syncthreads();
        f32x4 p0 = (f32x4){0.f, 0.f, 0.f, 0.f}, p1 = p0;
#pragma unroll
        for (int kk = 0; kk < 8; ++kk) {
            const bf16x8 qf = *(const LAS bf16x8*)(lds + QS + (nb * 16 + fr) * 528 + kk * 64 + fq * 16);
            const bf16x8 k0f = *(const LAS bf16x8*)(lds + KS + (mbase * 16 + fr) * 528 + kk * 64 + fq * 16);
            const bf16x8 k1f = *(const LAS bf16x8*)(lds + KS + ((mbase + 1) * 16 + fr) * 528 + kk * 64 + fq * 16);
            p0 = __builtin_amdgcn_mfma_f32_16x16x32_bf16(k0f, qf, p0, 0, 0, 0);
            p1 = __builtin_amdgcn_mfma_f32_16x16x32_bf16(k1f, qf, p1, 0, 0, 0);
        }
        const int n = nb * 16 + fr;
        bf16* dst = PB + ((size_t)u * 64 + n) * 64;
#pragma unroll
        for (int t = 0; t < 2; ++t) { const f32x4 p = t ? p1 : p0; const int m0 = (mbase + t) * 16 + 4 * fq; float d[4];
#pragma unroll
            for (int j = 0; j < 4; ++j) d[j] = exp2f(lg2 * (fabsf((float)(n - (m0 + j))) - (float)(63 - (m0 + j))));
            u32x2 pk; pk.x = cvt_pk_bf16(p[0] * d[0], p[1] * d[1]); pk.y = cvt_pk_bf16(p[2] * d[2], p[3] * d[3]);
            *(u32x2*)(dst + m0) = pk; }
    }
#undef SC_LOAD
    __syncthreads();
}
__device__ __forceinline__ void retention_phase(LAS unsigned char* lds, const bf16* QK, const bf16* KVT, const bf16* PB, bf16* O, int vcu, int G) {
    int tid_ = threadIdx.x; asm volatile("" : "+v"(tid_));
    const int tid = tid_, lane = tid & 63, w = __builtin_amdgcn_readfirstlane(tid >> 6), fr = lane & 15, fq = lane >> 4;
    constexpr int QS = 0, KTS = 33792, VTS = 70656, PS = 75264, STS = 84480;
    const bf16* VT = KVT;
    const int nb = w & 3, eb = w >> 2;
    const int trq = (lane & 15) >> 2, trp = lane & 3;
    for (int item = vcu; item < 256; item += G) {
        const int bh = item >> 4, es = item & 15, b = bh >> 2, h = bh & 3;
        const float lg2 = log2f(1.0f - exp2f(-5.0f - (float)h));
        const float qd = exp2f(lg2 * (float)(nb * 16 + fr + 1)), cd = exp2f(lg2 * 64.0f);
        f32x4 accS[2][2];
#pragma unroll
        for (int a = 0; a < 2; ++a)
#pragma unroll
            for (int c = 0; c < 2; ++c) accS[a][c] = (f32x4){0.f, 0.f, 0.f, 0.f};
        __syncthreads();
        for (int i = tid; i < 16896 / 4; i += 512) ((LAS unsigned*)(lds + STS))[i] = 0u;
        const size_t tokb = (size_t)b * SEQ;
        const bf16* gq = QK + (tokb + (tid >> 5)) * 2048 + h * 256 + (tid & 31) * 8;
        const bf16* gvt = VT + (size_t)(h * 512 + es * 32 + ((tid & 255) >> 3)) * 16384 + tokb + (tid & 7) * 8;
        const bf16* gp = PB + (size_t)bh * 64 * 4096 + tid * 8;
        u32x4 rq[4], rkt[4], rvt, rp;
#define RET_LOAD(ch) do { _Pragma("unroll") for (int k = 0; k < 4; ++k) { \
            rq[k] = *(const u32x4*)(gq + (size_t)((ch) * 64 + 16 * k) * 2048); \
            rkt[k] = *(const u32x4*)(gq + (size_t)((ch) * 64 + 16 * k) * 2048 + 1024); } \
            rvt = *(const u32x4*)(gvt + (ch) * 64); rp = *(const u32x4*)(gp + (size_t)(ch) * 4096); } while (0)
        RET_LOAD(0);
        for (int ch = 0; ch < 64; ++ch) {
#pragma unroll
            for (int k = 0; k < 4; ++k) {
                *(LAS u32x4*)(lds + QS + ((tid >> 5) + 16 * k) * 528 + (tid & 31) * 16) = rq[k];
                *(LAS u32x4*)(lds + KTS + ((tid >> 5) + 16 * k) * 544 + (tid & 31) * 16) = rkt[k]; }
            if (tid < 256) *(LAS u32x4*)(lds + VTS + (tid >> 3) * 144 + (tid & 7) * 16) = rvt;
            *(LAS u32x4*)(lds + PS + (tid >> 3) * 144 + (tid & 7) * 16) = rp;
            if (ch + 1 < 64) RET_LOAD(ch + 1);
            __syncthreads();
            f32x4 ao = (f32x4){0.f, 0.f, 0.f, 0.f};
#pragma unroll
            for (int kk = 0; kk < 8; ++kk) {
                const bf16x8 qf = *(const LAS bf16x8*)(lds + QS + (nb * 16 + fr) * 528 + kk * 64 + fq * 16);
                const bf16x8 sf = *(const LAS bf16x8*)(lds + STS + (eb * 16 + fr) * 528 + kk * 64 + fq * 16);
                ao = __builtin_amdgcn_mfma_f32_16x16x32_bf16(sf, qf, ao, 0, 0, 0);
            }
            ao = ao * qd;
#pragma unroll
            for (int kk = 0; kk < 2; ++kk) {
                const bf16x8 vf = *(const LAS bf16x8*)(lds + VTS + (eb * 16 + fr) * 144 + kk * 64 + fq * 16);
                const bf16x8 pf = *(const LAS bf16x8*)(lds + PS + (nb * 16 + fr) * 144 + kk * 64 + fq * 16);
                ao = __builtin_amdgcn_mfma_f32_16x16x32_bf16(vf, pf, ao, 0, 0, 0);
            }
            { u32x2 pk; pk.x = cvt_pk_bf16(ao[0], ao[1]); pk.y = cvt_pk_bf16(ao[2], ao[3]);
              *(u32x2*)(O + (tokb + ch * 64 + nb * 16 + fr) * 2048 + h * 512 + es * 32 + eb * 16 + 4 * fq) = pk; }
#pragma unroll
            for (int a = 0; a < 2; ++a)
#pragma unroll
                for (int c = 0; c < 2; ++c) accS[a][c] = accS[a][c] * cd;
#pragma unroll
            for (int kk = 0; kk < 2; ++kk) {
                const bf16x8 v0f = *(const LAS bf16x8*)(lds + VTS + fr * 144 + kk * 64 + fq * 16);
                const bf16x8 v1f = *(const LAS bf16x8*)(lds + VTS + (16 + fr) * 144 + kk * 64 + fq * 16);
#pragma unroll
                for (int di = 0; di < 2; ++di) {
                    const LAS unsigned char* kp = lds + KTS + (32 * kk + 8 * fq + trq) * 544 + 32 * (2 * w + di) + 8 * trp;
                    const s16x4_t klo = __builtin_bit_cast(s16x4_t, __builtin_amdgcn_ds_read_tr16_b64_v4i16((LAS s16x4_t*)kp));
                    const s16x4_t khi = __builtin_bit_cast(s16x4_t, __builtin_amdgcn_ds_read_tr16_b64_v4i16((LAS s16x4_t*)(kp + 4 * 544)));
                    const bf16x8 kf = __builtin_shufflevector(klo, khi, 0, 1, 2, 3, 4, 5, 6, 7);
                    accS[di][0] = __builtin_amdgcn_mfma_f32_16x16x32_bf16(kf, v0f, accS[di][0], 0, 0, 0);
                    accS[di][1] = __builtin_amdgcn_mfma_f32_16x16x32_bf16(kf, v1f, accS[di][1], 0, 0, 0);
                }
            }
            __syncthreads();
#pragma unroll
            for (int di = 0; di < 2; ++di)
#pragma unroll
                for (int c = 0; c < 2; ++c) { u32x2 pk; pk.x = cvt_pk_bf16(accS[di][c][0], accS[di][c][1]); pk.y = cvt_pk_bf16(accS[di][c][2], accS[di][c][3]);
                    *(LAS u32x2*)(lds + STS + (c * 16 + fr) * 528 + ((2 * w + di) * 16 + 4 * fq) * 2) = pk; }
        }
#undef RET_LOAD
    }
}

__device__ __forceinline__ void gn_gate_phase(const bf16* O, const bf16* Gt, bf16* A, int gw, int NGW, int lane) {
    for (int tok = gw; tok < NTOK; tok += NGW) {
#pragma unroll
        for (int hh = 0; hh < 4; ++hh) {
            const size_t off = (size_t)tok * 2048 + hh * 512 + lane * 8;
            const u32x4 ov = *(const u32x4*)(O + off), gv = *(const u32x4*)(Gt + off);
            float o[8], g[8]; unpack8(ov, o); unpack8(gv, g);
            float s = 0.f;
#pragma unroll
            for (int j = 0; j < 8; ++j) s += o[j];
            const float mean = wave_sum(s) * (1.0f / 512.0f); float q = 0.f;
#pragma unroll
            for (int j = 0; j < 8; ++j) { o[j] -= mean; q += o[j] * o[j]; }
            const float rstd = 1.0f / sqrtf(wave_sum(q) * (1.0f / 512.0f) + LN_EPS);
            float r[8];
#pragma unroll
            for (int j = 0; j < 8; ++j) { const float sg = g[j] * __builtin_amdgcn_rcpf(1.0f + __builtin_amdgcn_exp2f(-1.4426950408889634f * g[j])); r[j] = sg * o[j] * rstd; }
            u32x4 w; w.x = cvt_pk_bf16(r[0], r[1]); w.y = cvt_pk_bf16(r[2], r[3]); w.z = cvt_pk_bf16(r[4], r[5]); w.w = cvt_pk_bf16(r[6], r[7]);
            *(u32x4*)(A + off) = w;
        }
    }
}

__device__ __forceinline__ void ln_row(const float* rrow, const bf16* mrow, const float* gam, const float* bet, float* xfrow, bf16* xbrow, int lane, f32x4 (&v)[4]) {
    const f32x4* rr = (const f32x4*)rrow + lane; const u32x2* mr = (const u32x2*)mrow + lane; float s = 0.f;
#pragma unroll
    for (int j = 0; j < 4; ++j) { const u32x2 a = mr[64 * j];
        const f32x4 mv = (f32x4){__uint_as_float(a.x << 16), __uint_as_float(a.x & 0xffff0000u), __uint_as_float(a.y << 16), __uint_as_float(a.y & 0xffff0000u)};
        v[j] = rr[64 * j] * ALPHA + mv; s += (v[j][0] + v[j][1]) + (v[j][2] + v[j][3]); }
    const float mean = wave_sum(s) * (1.0f / DM); float q = 0.f;
#pragma unroll
    for (int j = 0; j < 4; ++j) { v[j] = v[j] - mean; q += (v[j][0] * v[j][0] + v[j][1] * v[j][1]) + (v[j][2] * v[j][2] + v[j][3] * v[j][3]); }
    const float rstd = 1.0f / sqrtf(wave_sum(q) * (1.0f / DM) + LN_EPS);
#pragma unroll
    for (int j = 0; j < 4; ++j) { const f32x4 gg = ((const f32x4*)gam)[lane + 64 * j], bb = ((const f32x4*)bet)[lane + 64 * j]; v[j] = v[j] * rstd * gg + bb;
        ((f32x4*)xfrow)[lane + 64 * j] = v[j];
        if (xbrow) { u32x2 w; w.x = cvt_pk_bf16(v[j][0], v[j][1]); w.y = cvt_pk_bf16(v[j][2], v[j][3]); ((u32x2*)xbrow)[lane + 64 * j] = w; } }
}
__device__ __forceinline__ void ln_phase_f8(const float* RES, const bf16* MIX, const float* gam, const float* bet, float* XF, unsigned char* X8, int gw, int NGW, int lane) {
    for (int m = gw; m < NTOK; m += NGW) { f32x4 v[4]; ln_row(RES + (size_t)m * DM, MIX + (size_t)m * DM, gam, bet, XF + (size_t)m * DM, nullptr, lane, v);
#pragma unroll
        for (int j = 0; j < 4; ++j) { int w = __builtin_amdgcn_cvt_pk_fp8_f32(pg8::sat8(v[j][0]), pg8::sat8(v[j][1]), 0, false); w = __builtin_amdgcn_cvt_pk_fp8_f32(pg8::sat8(v[j][2]), pg8::sat8(v[j][3]), w, true);
            ((unsigned*)(X8 + (size_t)m * DM))[lane + 64 * j] = (unsigned)w; } }
}
__device__ __forceinline__ void ln_phase(const float* RES, const bf16* MIX, const float* gam, const float* bet, float* XF, bf16* XB, int gw, int NGW, int lane) {
    for (int m = gw; m < NTOK; m += NGW) { f32x4 v[4]; ln_row(RES + (size_t)m * DM, MIX + (size_t)m * DM, gam, bet, XF + (size_t)m * DM, XB ? XB + (size_t)m * DM : nullptr, lane, v); }
}
__device__ __forceinline__ void ln_router_phase(LAS unsigned char* lds, const float* RES, const bf16* MIX, const float* gam, const float* bet, float* XF, bf16* XB, const float* wrt, unsigned char* ws, int gw, int NGW, int lane) {
    LAS float* wl = (LAS float*)lds;
    LAS int* lcnt = (LAS int*)(lds + 32768);
    LAS int* rl = (LAS int*)(lds + 32768 + 64);
    const int wave = threadIdx.x >> 6;
    __syncthreads();
    for (int i = threadIdx.x; i < 1024 * 8 / 4; i += 512) ((LAS f32x4*)wl)[i] = ((const f32x4*)wrt)[i];
    if (threadIdx.x < 16) lcnt[threadIdx.x] = 0;
    __syncthreads();
    int* cnt = (int*)(ws + WS_CTL);
    int* route = (int*)(ws + WS_ROUTE); float* wts = (float*)(ws + WS_ROUTE + 512 * 1024);
    int k = 0;
    for (int m = gw; m < NTOK; m += NGW, ++k) {
        f32x4 v[4]; ln_row(RES + (size_t)m * DM, MIX + (size_t)m * DM, gam, bet, XF + (size_t)m * DM, nullptr, lane, v);
#pragma unroll
        for (int j = 0; j < 4; ++j) { int w8 = __builtin_amdgcn_cvt_pk_fp8_f32(pg8::sat8(v[j][0]), pg8::sat8(v[j][1]), 0, false); w8 = __builtin_amdgcn_cvt_pk_fp8_f32(pg8::sat8(v[j][2]), pg8::sat8(v[j][3]), w8, true);
            ((unsigned*)((unsigned char*)XB + (size_t)m * DM))[lane + 64 * j] = (unsigned)w8; }
        float lg[8];
#pragma unroll
        for (int e = 0; e < 8; ++e) lg[e] = 0.f;
#pragma unroll
        for (int j = 0; j < 4; ++j)
#pragma unroll
            for (int c = 0; c < 4; ++c) { const int i = 256 * j + 4 * lane + c; const f32x4 w0 = ((const LAS f32x4*)wl)[2 * i], w1 = ((const LAS f32x4*)wl)[2 * i + 1]; const float xv = v[j][c];
                lg[0] += xv * w0[0]; lg[1] += xv * w0[1]; lg[2] += xv * w0[2]; lg[3] += xv * w0[3]; lg[4] += xv * w1[0]; lg[5] += xv * w1[1]; lg[6] += xv * w1[2]; lg[7] += xv * w1[3]; }
#pragma unroll
        for (int e = 0; e < 8; ++e) lg[e] = wave_sum(lg[e]);
        float v1 = lg[0]; int i1 = 0;
#pragma unroll
        for (int e = 1; e < 8; ++e) if (lg[e] > v1) { v1 = lg[e]; i1 = e; }
        float v2 = -3.0e38f; int i2 = 0;
#pragma unroll
        for (int e = 0; e < 8; ++e) if (e != i1 && lg[e] > v2) { v2 = lg[e]; i2 = e; }
        if (lane == 0) {
            const float ex = expf(v2 - v1), w1 = 1.0f / (1.0f + ex), w2 = ex / (1.0f + ex);
            const int p1 = __hip_atomic_fetch_add(lcnt + i1, 1, __ATOMIC_RELAXED, __HIP_MEMORY_SCOPE_WORKGROUP), p2 = __hip_atomic_fetch_add(lcnt + i2, 1, __ATOMIC_RELAXED, __HIP_MEMORY_SCOPE_WORKGROUP);
            LAS int* r = rl + (wave * 16 + (k & 15)) * 4; r[0] = i1; r[1] = p1; r[2] = i2; r[3] = p2;
            wts[2 * m] = w1; wts[2 * m + 1] = w2;
        }
    }
    __syncthreads();
    if (threadIdx.x < 8) lcnt[8 + threadIdx.x] = atomicAdd(cnt + threadIdx.x, lcnt[threadIdx.x]);
    __syncthreads();
    { const int t = threadIdx.x; const int wv = t >> 4, kk = t & 15;
      if (wv < 8) { const int m = (gw - wave + wv) + kk * NGW;
        if (kk < 16 && m < NTOK && t < 128) { const LAS int* r = rl + (wv * 16 + kk) * 4; const int e1 = r[0], e2 = r[2];
            route[4 * m] = e1; route[4 * m + 1] = lcnt[8 + e1] + r[1]; route[4 * m + 2] = e2; route[4 * m + 3] = lcnt[8 + e2] + r[3]; } } }
}
__device__ __forceinline__ void gather_phase(LAS unsigned char* lds, const bf16* XB, unsigned char* XP, unsigned char* ws, int gw, int NGW, int lane) {
    LAS int* offl = (LAS int*)lds;
    int* ctl = (int*)(ws + WS_CTL);
    __syncthreads();
    if (threadIdx.x == 0) { int off = 0;
        for (int e = 0; e < 8; ++e) { const int c = __hip_atomic_load(ctl + e, __ATOMIC_RELAXED, __HIP_MEMORY_SCOPE_AGENT); offl[e] = off;
            const int nt = (c + 255) >> 8;
            if (blockIdx.x == 0) for (int t = 0; t < nt; ++t) ctl[32 + (off >> 8) + t] = e;
            off += nt * 256; }
        offl[8] = off; if (blockIdx.x == 0) ctl[16] = off >> 8; }
    __syncthreads();
    const int* route = (const int*)(ws + WS_ROUTE); int* rows = (int*)(ws + WS_ROUTE + 768 * 1024);
    for (int m = gw; m < NTOK; m += NGW) {
        const int e1 = route[4 * m], p1 = route[4 * m + 1], e2 = route[4 * m + 2], p2 = route[4 * m + 3];
        const int r1 = offl[e1] + p1, r2 = offl[e2] + p2;
        const u32x4 o = ((const u32x4*)((const unsigned char*)XB + (size_t)m * DM))[lane];
        ((u32x4*)(XP + (size_t)r1 * DM))[lane] = o; ((u32x4*)(XP + (size_t)r2 * DM))[lane] = o;
        if (lane == 0) { rows[2 * m] = r1; rows[2 * m + 1] = r2; }
    }
}
__device__ __forceinline__ void final_phase(const float* XF, const bf16* YP, const float* gam, const float* bet, float* out, unsigned char* ws, int gw, int NGW, int lane) {
    const int* rows = (const int*)(ws + WS_ROUTE + 768 * 1024); const float* wts = (const float*)(ws + WS_ROUTE + 512 * 1024);
    for (int m = gw; m < NTOK; m += NGW) {
        const int r1 = rows[2 * m], r2 = rows[2 * m + 1]; const float w1 = wts[2 * m], w2 = wts[2 * m + 1];
        const f32x4* xr = (const f32x4*)(XF + (size_t)m * DM) + lane; const u32x2* y1 = (const u32x2*)(YP + (size_t)r1 * DM) + lane; const u32x2* y2 = (const u32x2*)(YP + (size_t)r2 * DM) + lane;
        f32x4 v[4]; float s = 0.f;
#pragma unroll
        for (int j = 0; j < 4; ++j) { const u32x2 a = y1[64 * j], b = y2[64 * j];
            const f32x4 ya = (f32x4){__uint_as_float(a.x << 16), __uint_as_float(a.x & 0xffff0000u), __uint_as_float(a.y << 16), __uint_as_float(a.y & 0xffff0000u)};
            const f32x4 yb = (f32x4){__uint_as_float(b.x << 16), __uint_as_float(b.x & 0xffff0000u), __uint_as_float(b.y << 16), __uint_as_float(b.y & 0xffff0000u)};
            v[j] = xr[64 * j] * ALPHA + (ya * w1 + yb * w2); s += (v[j][0] + v[j][1]) + (v[j][2] + v[j][3]); }
        const float mean = wave_sum(s) * (1.0f / DM); float q = 0.f;
#pragma unroll
        for (int j = 0; j < 4; ++j) { v[j] = v[j] - mean; q += (v[j][0] * v[j][0] + v[j][1] * v[j][1]) + (v[j][2] * v[j][2] + v[j][3] * v[j][3]); }
        const float rstd = 1.0f / sqrtf(wave_sum(q) * (1.0f / DM) + LN_EPS);
#pragma unroll
        for (int j = 0; j < 4; ++j) { const f32x4 gg = ((const f32x4*)gam)[lane + 64 * j], bb = ((const f32x4*)bet)[lane + 64 * j];
            ((f32x4*)(out + (size_t)m * DM))[lane + 64 * j] = v[j] * rstd * gg + bb; }
    }
}

#ifndef SB_CUT
#define SB_CUT (-150.1f)
#endif
__device__ __forceinline__ void sb_attn_phase(LAS unsigned char* lds, const bf16* KQ, const bf16* VT2, bf16* O, int vcu, int G) {
    int tid_ = threadIdx.x; asm volatile("" : "+v"(tid_));
    const int tid = tid_, lane = tid & 63, w = __builtin_amdgcn_readfirstlane(tid >> 6), fr = lane & 15, fq = lane >> 4;
    constexpr int VB = 18432, FLG = 36864;
    volatile LAS int* flags = (volatile LAS int*)(lds + FLG);
    bf16x8 tri[4][2];
#pragma unroll
    for (int a = 0; a < 4; ++a)
#pragma unroll
        for (int ks = 0; ks < 2; ++ks)
#pragma unroll
            for (int j = 0; j < 8; ++j) { const int sk = 16 * (2 * ks + (j >> 2)) + 4 * fq + (j & 3), sp = 16 * a + fr; tri[a][ks][j] = (sk >= sp) ? (short)0x3F80 : (short)0; }
    for (int L = vcu; L < 1024; L += G) {
        const int bh = L >> 4; int qb = L & 15; if ((L >> 8) & 1) qb = 15 - qb;
        const int b = bh >> 4, h = bh & 15;
        const int q0 = qb * 256, tw = q0 + 32 * w;
        const size_t tokb = (size_t)b * SEQ;
        bf16x8 qf[2][2];
#pragma unroll
        for (int qi = 0; qi < 2; ++qi)
#pragma unroll
            for (int kk = 0; kk < 2; ++kk) qf[qi][kk] = *(const bf16x8*)(KQ + (tokb + tw + 16 * qi + fr) * 2048 + 1024 + h * 64 + kk * 32 + 8 * fq);
        f32x4 oacc[2][4];
#pragma unroll
        for (int qi = 0; qi < 2; ++qi)
#pragma unroll
            for (int d = 0; d < 4; ++d) oacc[qi][d] = (f32x4){0.f, 0.f, 0.f, 0.f};
        float R0 = 0.f, R1 = 0.f; int done = 0;
        const int ntile = (q0 + 256) >> 6;
        const bf16* gk = KQ + (tokb + (tid >> 3)) * 2048 + h * 64 + (tid & 7) * 8;
        const bf16* gv = VT2 + (size_t)(h * 64 + (tid >> 3)) * 16384 + tokb + (tid & 7) * 8;
        const int lwo = (tid >> 3) * 144 + (tid & 7) * 16;
        __syncthreads();
        if (tid < 16) flags[tid] = 0;
        u32x4 rk = *(const u32x4*)(gk + (size_t)((ntile - 1) * 64) * 2048), rv = *(const u32x4*)(gv + (ntile - 1) * 64);
        *(LAS u32x4*)(lds + lwo) = rk; *(LAS u32x4*)(lds + VB + lwo) = rv;
        int cur = 0;
        for (int it = 0; it < ntile; ++it) {
            const int j0 = (ntile - 1 - it) * 64;
            __syncthreads();
            { int all = 1;
#pragma unroll
              for (int i = 0; i < 8; ++i) all &= flags[(it & 1) * 8 + i];
              if (all) break; }
            if (it + 1 < ntile) { rk = *(const u32x4*)(gk + (size_t)(j0 - 64) * 2048); rv = *(const u32x4*)(gv + (j0 - 64)); }
            if (!done && j0 < tw + 32) {
                const bool need_mask = (j0 + 63 >= tw);
                const LAS unsigned char* kb = lds + cur * 9216; const LAS unsigned char* vb = lds + VB + cur * 9216;
                bf16x8 kf[4][2];
#pragma unroll
                for (int a = 0; a < 4; ++a)
#pragma unroll
                    for (int kk = 0; kk < 2; ++kk) kf[a][kk] = *(const LAS bf16x8*)(kb + (16 * a + fr) * 144 + kk * 64 + fq * 16);
                bf16x8 pf[2][2]; bool act0 = false, act1 = false;
#pragma unroll
                for (int qi = 0; qi < 2; ++qi) {
                    const int t = tw + 16 * qi + fr;
                    const bool act = (j0 < tw + 16 * qi + 16) && !__all((qi ? R1 : R0) < SB_CUT);
                    if (qi) act1 = act; else act0 = act;
                    if (!act) continue;
                    f32x4 z[4], lk[4];
#pragma unroll
                    for (int a = 0; a < 4; ++a) { z[a] = __builtin_amdgcn_mfma_f32_16x16x32_bf16(kf[a][0], qf[qi][0], (f32x4){0.f, 0.f, 0.f, 0.f}, 0, 0, 0);
                        z[a] = __builtin_amdgcn_mfma_f32_16x16x32_bf16(kf[a][1], qf[qi][1], z[a], 0, 0, 0); }
#pragma unroll
                    for (int a = 0; a < 4; ++a)
#pragma unroll
                        for (int j = 0; j < 4; ++j) { const float zz = z[a][j]; const float e = __builtin_amdgcn_exp2f(-fabsf(zz)); float v = -(fmaxf(zz, 0.f) + __builtin_amdgcn_logf(1.0f + e));
                            if (need_mask) { const int s = j0 + 16 * a + 4 * fq + j; if (s >= t) v = 0.f; }
                            lk[a][j] = v; }
                    bf16x8 lf[2];
#pragma unroll
                    for (int ks = 0; ks < 2; ++ks) { u32x4 pk; pk.x = cvt_pk_bf16(lk[2 * ks][0], lk[2 * ks][1]); pk.y = cvt_pk_bf16(lk[2 * ks][2], lk[2 * ks][3]);
                        pk.z = cvt_pk_bf16(lk[2 * ks + 1][0], lk[2 * ks + 1][1]); pk.w = cvt_pk_bf16(lk[2 * ks + 1][2], lk[2 * ks + 1][3]); lf[ks] = __builtin_bit_cast(bf16x8, pk); }
                    const float Rv = qi ? R1 : R0;
                    f32x4 c[4];
#pragma unroll
                    for (int a = 0; a < 4; ++a) { c[a] = (f32x4){Rv, Rv, Rv, Rv};
                        if (a < 2) c[a] = __builtin_amdgcn_mfma_f32_16x16x32_bf16(tri[a][0], lf[0], c[a], 0, 0, 0);
                        c[a] = __builtin_amdgcn_mfma_f32_16x16x32_bf16(tri[a][1], lf[1], c[a], 0, 0, 0); }
                    f32x4 wv[4];
#pragma unroll
                    for (int a = 0; a < 4; ++a)
#pragma unroll
                        for (int j = 0; j < 4; ++j) { float x = __builtin_amdgcn_exp2f(z[a][j] + c[a][j]);
                            if (need_mask) { const int s = j0 + 16 * a + 4 * fq + j; if (s >= t) x = 0.f; }
                            wv[a][j] = x; }
#pragma unroll
                    for (int ks = 0; ks < 2; ++ks) { u32x4 pk; pk.x = cvt_pk_bf16(wv[2 * ks][0], wv[2 * ks][1]); pk.y = cvt_pk_bf16(wv[2 * ks][2], wv[2 * ks][3]);
                        pk.z = cvt_pk_bf16(wv[2 * ks + 1][0], wv[2 * ks + 1][1]); pk.w = cvt_pk_bf16(wv[2 * ks + 1][2], wv[2 * ks + 1][3]); pf[qi][ks] = __builtin_bit_cast(bf16x8, pk); }
                    const float Rn = __shfl(c[0][0], fr);
                    if (qi) R1 = Rn; else R0 = Rn;
                }
#pragma unroll
                for (int d = 0; d < 4; ++d)
#pragma unroll
                    for (int ks = 0; ks < 2; ++ks) {
                        const u32x2 lo = *(const LAS u32x2*)(vb + (16 * d + fr) * 144 + (32 * ks + 4 * fq) * 2);
                        const u32x2 hi = *(const LAS u32x2*)(vb + (16 * d + fr) * 144 + (32 * ks + 16 + 4 * fq) * 2);
                        u32x4 vv; vv.x = lo.x; vv.y = lo.y; vv.z = hi.x; vv.w = hi.y; const bf16x8 vf = __builtin_bit_cast(bf16x8, vv);
                        if (act0) oacc[0][d] = __builtin_amdgcn_mfma_f32_16x16x32_bf16(vf, pf[0][ks], oacc[0][d], 0, 0, 0);
                        if (act1) oacc[1][d] = __builtin_amdgcn_mfma_f32_16x16x32_bf16(vf, pf[1][ks], oacc[1][d], 0, 0, 0);
                    }
                done = __all((R0 < SB_CUT) && (R1 < SB_CUT)) ? 1 : 0;
            }
            if (lane == 0) flags[((it + 1) & 1) * 8 + w] = done;
            if (it + 1 < ntile) { *(LAS u32x4*)(lds + (cur ^ 1) * 9216 + lwo) = rk; *(LAS u32x4*)(lds + VB + (cur ^ 1) * 9216 + lwo) = rv; }
            cur ^= 1;
        }
#pragma unroll
        for (int qi = 0; qi < 2; ++qi)
#pragma unroll
            for (int d = 0; d < 4; ++d) { u32x2 pk; pk.x = cvt_pk_bf16(oacc[qi][d][0], oacc[qi][d][1]); pk.y = cvt_pk_bf16(oacc[qi][d][2], oacc[qi][d][3]);
                *(u32x2*)(O + (tokb + tw + 16 * qi + fr) * DM + h * 64 + 16 * d + 4 * fq) = pk; }
    }
}

__global__ void __launch_bounds__(512, 2) fwd_megakernel(Ptrs P) {
    extern __shared__ __attribute__((aligned(16))) unsigned char lds_raw[];
    LAS unsigned char* lds = (LAS unsigned char*)lds_raw;
    cg::grid_group grid = cg::this_grid();
#define GRID_SYNC() do { asm volatile("s_waitcnt vmcnt(0) lgkmcnt(0)" ::: "memory"); grid.sync(); __builtin_amdgcn_fence(__ATOMIC_ACQUIRE, "agent"); asm volatile("s_waitcnt vmcnt(0)" ::: "memory"); } while (0)
    const int tid = threadIdx.x, lane = tid & 63, wave = __builtin_amdgcn_readfirstlane(tid >> 6);
    const int G = gridDim.x, bx = blockIdx.x;
#ifndef REP_MASK
#define REP_MASK 0
#endif
#define REPS(k) for (int rep_ = 0; rep_ < 1 + ((REP_MASK >> (k)) & 1); ++rep_)
#ifndef DIAG_STOP
#define DIAG_STOP 0
#endif

#define DIAG_BF(k, expr_n, body) do { if (DIAG_STOP == (k)) { float* d_ = P.out; for (int i_ = blockIdx.x * 512 + threadIdx.x; i_ < NTOK * DM; i_ += gridDim.x * 512) { float r_ = 0.f; body; d_[i_] = r_; } return; } } while (0)
#define DIAG_OUT(k) do { if (DIAG_STOP == (k)) { const f32x4* s_ = (const f32x4*)(P.ws + WS_XF); f32x4* d_ = (f32x4*)P.out; for (int i_ = blockIdx.x * 512 + threadIdx.x; i_ < NTOK * DM / 4; i_ += gridDim.x * 512) d_[i_] = s_[i_]; return; } } while (0)
    const int vcu = (G % 8 == 0) ? (bx % 8) * (G / 8) + bx / 8 : bx;
    const int gw = vcu * 8 + wave, NGW = G * 8, gtid = bx * 512 + tid, NT = G * 512;
    unsigned char* ws = P.ws;
    if (tid < 16) ((volatile LAS unsigned*)(lds + 141312))[tid] = 0u;
    __syncthreads();
    bf16* XB = (bf16*)(ws + WS_XB); float* XF = (float*)(ws + WS_XF); bf16* MIX = (bf16*)(ws + WS_Y);
    const float* cosN = (const float*)(ws + WS_ROPE); const float* sinN = cosN + 4096 * 128; const float* cosT = sinN + 4096 * 128; const float* sinT = cosT + 4096 * 128;
    const float* kdt = (const float*)(ws + WS_CTL) + 1024;

    if (ws == nullptr) grid.sync();
    XcdBarrier xbar = xcd_barrier_post((unsigned*)(ws + WS_CTL) + 4096, (volatile LAS unsigned*)(lds + 141312));
    REPS(0) phase0(P, lds, gw, NGW, opq(lane), opq(gtid), NT);
    xcd_barrier(xbar);
    if ((REP_MASK >> 20) & 1) { for (int q_ = 0; q_ < 8; ++q_) xcd_barrier(xbar); }

    { bf16* QK = (bf16*)(ws + WS_RA); bf16* Gt = (bf16*)(ws + WS_RA + 64 * MiB); bf16* KVT = (bf16*)(ws + WS_RA + 128 * MiB);
      REPS(1) { pg8::Gemm g{XB, (const bf16*)(ws + WS_W1A), NTOK, 4096, 1024}; pg8::StaticOrder S; S.init(NTOK, 4096, G, bx);
        pg8::EpiRetNat E{QK, Gt, cosN, sinN, kdt};
        pg8::gemm_phase<pg8::EpiRetNat, pg8::StaticOrder, true, true>(lds, g, S, E); }
      REPS(1) { pg8::Gemm g{(const bf16*)(ws + WS_W1B), XB, 2048, NTOK, 1024}; pg8::StaticOrder S; S.init(2048, NTOK, G, bx, WGM_T);
        pg8::EpiBf16Plain E{KVT, NTOK, 0.f, 0};
        pg8::gemm_phase<pg8::EpiBf16Plain, pg8::StaticOrder, true, true>(lds, g, S, E); }
      xcd_barrier(xbar);
      DIAG_BF(11, 0, { r_ = bf2f(QK[2 * (size_t)i_]) + 1.37f * bf2f(QK[2 * (size_t)i_ + 1]) + 0.61f * bf2f(Gt[2 * (size_t)i_]) + 0.83f * bf2f(Gt[2 * (size_t)i_ + 1]) + 1.11f * bf2f(KVT[3 * (size_t)i_]) + 0.77f * bf2f(KVT[3 * (size_t)i_ + 1]) + 1.51f * bf2f(KVT[3 * (size_t)i_ + 2]); });
      bf16* ORET = (bf16*)(ws + WS_RB); bf16* ARET = (bf16*)(ws + WS_RB + 64 * MiB);
      bf16* PB = (bf16*)(ws + WS_RB + 128 * MiB);
      REPS(5) ret_scores_phase(lds, QK, PB, vcu, G);
      xcd_barrier(xbar);
      REPS(2) retention_phase(lds, QK, KVT, PB, ORET, vcu, G);
      xcd_barrier(xbar);
      DIAG_BF(12, 0, { r_ = bf2f(ORET[2 * (size_t)i_]) + 1.37f * bf2f(ORET[2 * (size_t)i_ + 1]); });
      REPS(3) gn_gate_phase(ORET, Gt, ARET, gw, NGW, opq(lane));
      xcd_barrier(xbar);
      DIAG_BF(13, 0, { r_ = bf2f(ARET[2 * (size_t)i_]) + 1.37f * bf2f(ARET[2 * (size_t)i_ + 1]); });
      REPS(4) { pg8::Gemm g{ARET, (const bf16*)(ws + WS_W4), NTOK, 1024, 2048}; pg8::StaticOrder S; S.init(NTOK, 1024, G, bx);
        pg8::EpiBf16Plain E{MIX, DM, 0.f, 0};
        pg8::gemm_phase<pg8::EpiBf16Plain, pg8::StaticOrder, true, true>(lds, g, S, E); }
      xcd_barrier(xbar); }
    REPS(3) ln_phase_f8(P.x, MIX, P.ln_mix_g, P.ln_mix_b, XF, (unsigned char*)XB, gw, NGW, opq(lane));
    xcd_barrier(xbar);
    DIAG_OUT(1);
    { bf16* H = (bf16*)(ws + WS_RA);
      REPS(6) { pg8::Gemm g{XB, (const bf16*)(ws + WS_W6), NTOK, 2 * DFF, 1024}; pg8::StaticOrder S; S.init(NTOK, 2 * DFF, G, bx);
        pg8::EpiSwiglu E{H, DFF, 0, 1.0f / W6_SCALE, H_SCALE};
        pg8::gemm_phase<pg8::EpiSwiglu, pg8::StaticOrder, true, true, true>(lds, g, S, E); }
      xcd_barrier(xbar);
      REPS(7) { pg8::Gemm g{H, (const bf16*)(ws + WS_W7), NTOK, 1024, DFF}; pg8::StaticOrder S; S.init(NTOK, 1024, G, bx);
        pg8::EpiBf16Plain E{MIX, DM, 1.0f / (W7_SCALE * H_SCALE), 0};
        pg8::gemm_phase<pg8::EpiBf16Plain, pg8::StaticOrder, true, true, true>(lds, g, S, E); }
      xcd_barrier(xbar); }
    REPS(3) ln_phase(XF, MIX, P.ln_ffn_g, P.ln_ffn_b, XF, XB, gw, NGW, opq(lane));
    xcd_barrier(xbar);
    DIAG_OUT(2);
    { bf16* KQ = (bf16*)(ws + WS_RA); bf16* VT2 = (bf16*)(ws + WS_RA + 64 * MiB); bf16* OATT = (bf16*)(ws + WS_RB);
      REPS(9) { pg8::Gemm g{XB, (const bf16*)(ws + WS_W9A), NTOK, 2048, 1024}; pg8::StaticOrder S; S.init(NTOK, 2048, G, bx);
        pg8::EpiBf16Plain E{KQ, 2048, 0.f, 0};
        pg8::gemm_phase<pg8::EpiBf16Plain, pg8::StaticOrder, true, true>(lds, g, S, E); }
      REPS(9) { pg8::Gemm g{(const bf16*)(ws + WS_W9B), XB, 1024, NTOK, 1024}; pg8::StaticOrder S; S.init(1024, NTOK, G, bx, WGM_T);
        pg8::EpiBf16Plain E{VT2, NTOK, 0.f, 0};
        pg8::gemm_phase<pg8::EpiBf16Plain, pg8::StaticOrder, true, true>(lds, g, S, E); }
      xcd_barrier(xbar);
      REPS(10) sb_attn_phase(lds, KQ, VT2, OATT, vcu, G);
      xcd_barrier(xbar);
      REPS(11) { pg8::Gemm g{OATT, (const bf16*)(ws + WS_W11), NTOK, 1024, 1024}; pg8::StaticOrder S; S.init(NTOK, 1024, G, bx);
        pg8::EpiBf16Plain E{MIX, DM, 0.f, 0};
        pg8::gemm_phase<pg8::EpiBf16Plain, pg8::StaticOrder, true, true>(lds, g, S, E); }
      xcd_barrier(xbar); }
    ln_router_phase(lds, XF, MIX, P.ln_mix_g + DM, P.ln_mix_b + DM, XF, XB, P.moe_w_router, ws, gw, NGW, opq(lane));
    xcd_barrier(xbar);
    DIAG_OUT(3);
    { unsigned char* XP = ws + WS_RB; bf16* H2 = (bf16*)(ws + WS_RA); bf16* YP = (bf16*)(ws + WS_RB);
      REPS(3) gather_phase(lds, XB, XP, ws, gw, NGW, opq(lane));
      xcd_barrier(xbar);
      const int* ctl = (const int*)(ws + WS_CTL);
      const int ntiles = __builtin_amdgcn_readfirstlane(__hip_atomic_load(ctl + 16, __ATOMIC_RELAXED, __HIP_MEMORY_SCOPE_AGENT));
      REPS(13) { pg8::Gemm g{(const bf16*)XP, (const bf16*)(ws + WS_W13), ntiles * 256, 28 * 256, 1024}; pg8::MoeOrder S; S.init(ntiles * 256, 28 * 256, G, bx); S.tile_e = ctl + 32; S.NT = 28;
        pg8::EpiSwiglu E{H2, DEXP, 28, 1.0f / W13_SCALE, H2_SCALE};
        pg8::gemm_phase<pg8::EpiSwiglu, pg8::MoeOrder, true, true, true>(lds, g, S, E); }
      xcd_barrier(xbar);
      REPS(14) { pg8::Gemm g{H2, (const bf16*)(ws + WS_W14), ntiles * 256, 4 * 256, DEXP}; pg8::MoeOrder S; S.init(ntiles * 256, 4 * 256, G, bx); S.tile_e = ctl + 32; S.NT = 4;
        pg8::EpiBf16Plain E{YP, DM, 1.0f / (W14_SCALE * H2_SCALE), 4};
        pg8::gemm_phase<pg8::EpiBf16Plain, pg8::MoeOrder, true, true, true>(lds, g, S, E); }
      xcd_barrier(xbar);
      REPS(3) final_phase(XF, YP, P.ln_ffn_g + DM, P.ln_ffn_b + DM, P.out, ws, gw, NGW, opq(lane)); }
}

extern "C" void kernel_launch(void* const* d_in, const int* in_sizes, int n_in, void* d_out, int out_size, void* d_ws, size_t ws_size, hipStream_t stream) {
    static int grid = 0;
    if (grid == 0) {
        if (n_in != 15 || ws_size < WS_END) { fprintf(stderr, "kernel_launch: unexpected n_in %d / ws_size %zu (need %zu)\n", n_in, ws_size, (size_t)WS_END); grid = -1; return; }
        int dev = 0, cus = 0, per_cu = 0;
        hipGetDevice(&dev); hipDeviceGetAttribute(&cus, hipDeviceAttributeMultiprocessorCount, dev);
        if (hipFuncSetAttribute((const void*)fwd_megakernel, hipFuncAttributeMaxDynamicSharedMemorySize, LDS_BYTES) != hipSuccess) { fprintf(stderr, "kernel_launch: hipFuncSetAttribute failed\n"); grid = -1; return; }
        if (hipOccupancyMaxActiveBlocksPerMultiprocessor(&per_cu, (const void*)fwd_megakernel, 512, LDS_BYTES) != hipSuccess || per_cu < 1) { fprintf(stderr, "kernel_launch: occupancy query failed (%d)\n", per_cu); per_cu = 1; }
        (void)hipGetLastError();
        grid = cus * (per_cu > 1 ? 1 : per_cu);
        fprintf(stderr, "kernel_launch: cus %d per_cu %d grid %d\n", cus, per_cu, grid);
    }
    if (grid < 0) return;
    Ptrs p{};
    p.x = (const float*)d_in[0]; p.ret_w_in = (const float*)d_in[1]; p.ret_w_out = (const float*)d_in[2]; p.sb_w_kv = (const float*)d_in[3]; p.sb_w_q = (const float*)d_in[4];
    p.sb_w_out = (const float*)d_in[5]; p.ln_mix_g = (const float*)d_in[6]; p.ln_mix_b = (const float*)d_in[7]; p.ln_ffn_g = (const float*)d_in[8]; p.ln_ffn_b = (const float*)d_in[9];
    p.ffn_w_in = (const float*)d_in[10]; p.ffn_w_out = (const float*)d_in[11]; p.moe_w_router = (const float*)d_in[12]; p.moe_w_in = (const float*)d_in[13]; p.moe_w_out = (const float*)d_in[14];
    p.out = (float*)d_out; p.ws = (unsigned char*)d_ws;
    if (hipMemsetAsync((unsigned char*)d_ws + WS_CTL + 4096 * 4, 0, XCD_BAR_WORDS * 4, stream) != hipSuccess) { fprintf(stderr, "kernel_launch: hipMemsetAsync of the barrier words failed\n"); return; }
    void* args[] = {&p};
    hipError_t e = hipLaunchCooperativeKernel((const void*)fwd_megakernel, dim3(grid), dim3(512), args, LDS_BYTES, stream);
    if (e != hipSuccess) fprintf(stderr, "kernel_launch: cooperative launch failed: %s (grid %d)\n", hipGetErrorString(e), grid);
}
```
